# Optimizing an MI355X kernel written in HIP

```python
import math
import jax, jax.numpy as jnp
from jax import lax
import numpy as np


D_MODEL = 2048
BATCH = 4
SEQ = 4096
DEPTH = 4
DEC_BATCH = 32
DEC_SEQ = 32
PAST_LEN = 1024

CHUNK = 64
N_A_LAYERS = DEPTH // 2
N_B_LAYERS = DEPTH - N_A_LAYERS
RET_HEADS = 8
RET_DK = D_MODEL // RET_HEADS
RET_DV = 2 * D_MODEL // RET_HEADS
DIFF_HEADS = 8
DIFF_HD = D_MODEL // (2 * DIFF_HEADS)
D_FF = 4 * D_MODEL
Q_BLOCK = 128
EPS = 1e-6

kernel_name = 'yoco_retention_diffattn_stream'


def rmsnorm(x, g=None):
    xf = x.astype(jnp.float32)
    y = xf * lax.rsqrt(jnp.mean(xf * xf, axis=-1, keepdims=True) + EPS)
    if g is not None:
        y = y * g.astype(jnp.float32)
    return y.astype(x.dtype)


def retention_scan(q, k, v, s0):
    B, T = q.shape[:2]
    C = min(CHUNK, T)
    n = T // C
    lg = jnp.log1p(-jnp.exp2(-5.0 - jnp.arange(RET_HEADS, dtype=jnp.float32)))
    i = jnp.arange(C, dtype=jnp.float32)
    dif = i[:, None] - i[None, :]
    decay_in = jnp.where(dif >= 0, jnp.exp(lg[:, None, None] * jnp.maximum(dif, 0.0)), 0.0)
    q_dec = jnp.exp(lg[None, :] * (i[:, None] + 1.0))
    k_dec = jnp.exp(lg[None, :] * (C - 1.0 - i[:, None]))
    c_dec = jnp.exp(lg * C)

    def to_chunks(a):
        return jnp.moveaxis(a.astype(jnp.float32).reshape(B, n, C, *a.shape[2:]), 1, 0)

    def step(S, qkv):
        qc, kc, vc = qkv
        sc = jnp.einsum('bihd,bjhd->bhij', qc, kc) * decay_in
        o = (jnp.einsum('bhij,bjhe->bihe', sc, vc)
             + jnp.einsum('bihd,bhde->bihe', qc * q_dec[None, :, :, None], S))
        S = S * c_dec[None, :, None, None] + jnp.einsum('bjhd,bjhe->bhde', kc * k_dec[None, :, :, None], vc)
        return S, o

    S, o = lax.scan(step, s0.astype(jnp.float32), (to_chunks(q), to_chunks(k), to_chunks(v)))
    o = jnp.moveaxis(o, 0, 1).reshape(B, T, RET_HEADS, RET_DV)
    return o.astype(v.dtype), S.astype(s0.dtype)


def retention_mixer(h, s0, w_in, w_out):
    B, T, _ = h.shape
    proj = h @ w_in
    q, k, v, g = jnp.split(proj, [D_MODEL, 2 * D_MODEL, 4 * D_MODEL], axis=-1)
    q = q.reshape(B, T, RET_HEADS, RET_DK)
    k = k.reshape(B, T, RET_HEADS, RET_DK) * (RET_DK ** -0.5)
    v = v.reshape(B, T, RET_HEADS, RET_DV)
    o, s_new = retention_scan(q, k, v, s0)
    o = rmsnorm(o).reshape(B, T, RET_HEADS * RET_DV)
    return (jax.nn.silu(g) * o) @ w_out, s_new


def shared_kv(x, g_kv, w_kv):
    B, T, _ = x.shape
    k, v = jnp.split(rmsnorm(x, g_kv) @ w_kv, [D_MODEL], axis=-1)
    return (k.reshape(B, T, DIFF_HEADS, 2, DIFF_HD), v.reshape(B, T, DIFF_HEADS, 2 * DIFF_HD))


def diff_attention(q, k, v, q_pos, k_pos, lam):
    B, Tq = q.shape[:2]
    qb = min(Q_BLOCK, Tq)
    nb = Tq // qb
    slopes = jnp.exp2(-8.0 * (jnp.arange(DIFF_HEADS, dtype=jnp.float32) + 1.0) / DIFF_HEADS)
    kf = k.astype(jnp.float32)
    vf = v.astype(jnp.float32)
    scale = DIFF_HD ** -0.5

    def block(args):
        qblk, pos = args
        s = jnp.einsum('bqhmd,bkhmd->bhmqk', qblk.astype(jnp.float32), kf) * scale
        dist = jnp.abs(pos[:, None] - k_pos[None, :]).astype(jnp.float32)
        visible = k_pos[None, :] < (pos[:, None] // CHUNK + 1) * CHUNK
        s = jnp.where(visible, s - slopes[:, None, None, None] * dist, -jnp.inf)
        p = jax.nn.softmax(s, axis=-1)
        a = p[:, :, 0] - lam * p[:, :, 1]
        return jnp.einsum('bhqk,bkhe->bqhe', a, vf)

    qs = jnp.moveaxis(q.reshape(B, nb, qb, *q.shape[2:]), 1, 0)
    ps = q_pos.reshape(nb, qb)
    o = lax.map(block, (qs, ps))
    return jnp.moveaxis(o, 0, 1).reshape(B, Tq, DIFF_HEADS, 2 * DIFF_HD).astype(v.dtype)


def diff_mixer(h, k, v, q_pos, k_pos, w_q, lam_p, g_sub, w_out, lambda_init):
    B, T, _ = h.shape
    q = (h @ w_q).reshape(B, T, DIFF_HEADS, 2, DIFF_HD)
    lp = lam_p.astype(jnp.float32)
    lam = jnp.exp(jnp.sum(lp[0] * lp[1])) - jnp.exp(jnp.sum(lp[2] * lp[3])) + lambda_init
    o = diff_attention(q, k, v, q_pos, k_pos, lam)
    o = rmsnorm(o, g_sub) * (1.0 - lambda_init)
    return o.reshape(B, T, DIFF_HEADS * 2 * DIFF_HD) @ w_out


def sq_relu_mlp(h, w_up, w_down):
    return jnp.square(jax.nn.relu(h @ w_up)) @ w_down


def trunk(x, ret_state, cache_k, cache_v, norm_mix_pre, norm_mix_post, norm_ffn_pre, norm_ffn_post,
          ret_w_in, ret_w_out, kv_norm, w_kv, diff_w_q, diff_lambda, diff_g_sub, diff_w_out,
          mlp_w_up, mlp_w_down):
    T = x.shape[1]
    past = cache_k.shape[1]
    q_pos = past + jnp.arange(T, dtype=jnp.int32)
    k_pos = jnp.arange(past + T, dtype=jnp.int32)
    new_states = []
    k_new = v_new = k_all = v_all = None
    for layer in range(DEPTH):
        h = rmsnorm(x, norm_mix_pre[layer])
        if layer < N_A_LAYERS:
            m, s = retention_mixer(h, ret_state[layer], ret_w_in[layer], ret_w_out[layer])
            new_states.append(s)
        else:
            j = layer - N_A_LAYERS
            lambda_init = 0.8 - 0.6 * math.exp(-0.3 * layer)
            m = diff_mixer(h, k_all, v_all, q_pos, k_pos, diff_w_q[j], diff_lambda[j],
                           diff_g_sub[j], diff_w_out[j], lambda_init)
        x = x + rmsnorm(m, norm_mix_post[layer])
        f = sq_relu_mlp(rmsnorm(x, norm_ffn_pre[layer]), mlp_w_up[layer], mlp_w_down[layer])
        x = x + rmsnorm(f, norm_ffn_post[layer])
        if layer == N_A_LAYERS - 1:
            k_new, v_new = shared_kv(x, kv_norm, w_kv)
            k_all = jnp.concatenate([cache_k, k_new], axis=1)
            v_all = jnp.concatenate([cache_v, v_new], axis=1)
    return x, jnp.stack(new_states), k_new, v_new


def setup_inputs(seed: int = 0) -> dict:
    key = jax.random.key(seed)
    ks = jax.random.split(key, 20)
    f32 = jnp.float32

    def w(k, shape, fan_in):
        return jax.random.normal(k, shape, f32) * (fan_in ** -0.5)

    def gain(k, shape):
        return 1.0 + 0.05 * jax.random.normal(k, shape, f32)

    return {
        'x_prompt': jax.random.normal(ks[0], (BATCH, SEQ, D_MODEL), f32),
        'x_sample': jax.random.normal(ks[1], (DEC_BATCH, DEC_SEQ, D_MODEL), f32),
        'state_ret': 0.5 * jax.random.normal(ks[2], (N_A_LAYERS, DEC_BATCH, RET_HEADS, RET_DK, RET_DV), f32),
        'cache_k': jax.random.normal(ks[3], (DEC_BATCH, PAST_LEN, DIFF_HEADS, 2, DIFF_HD), f32),
        'cache_v': jax.random.normal(ks[4], (DEC_BATCH, PAST_LEN, DIFF_HEADS, 2 * DIFF_HD), f32),
        'norm_mix_pre': gain(ks[5], (DEPTH, D_MODEL)),
        'norm_mix_post': gain(ks[6], (DEPTH, D_MODEL)),
        'norm_ffn_pre': gain(ks[7], (DEPTH, D_MODEL)),
        'norm_ffn_post': gain(ks[8], (DEPTH, D_MODEL)),
        'ret_w_in': w(ks[9], (N_A_LAYERS, D_MODEL, 6 * D_MODEL), D_MODEL),
        'ret_w_out': w(ks[10], (N_A_LAYERS, 2 * D_MODEL, D_MODEL), 2 * D_MODEL),
        'kv_norm': gain(ks[11], (D_MODEL,)),
        'w_kv': w(ks[12], (D_MODEL, 2 * D_MODEL), D_MODEL),
        'diff_w_q': w(ks[13], (N_B_LAYERS, D_MODEL, D_MODEL), D_MODEL),
        'diff_lambda': 0.1 * jax.random.normal(ks[14], (N_B_LAYERS, 4, DIFF_HD), f32),
        'diff_g_sub': gain(ks[15], (N_B_LAYERS, 2 * DIFF_HD)),
        'diff_w_out': w(ks[16], (N_B_LAYERS, D_MODEL, D_MODEL), D_MODEL),
        'mlp_w_up': w(ks[17], (DEPTH, D_MODEL, D_FF), D_MODEL),
        'mlp_w_down': w(ks[18], (DEPTH, D_FF, D_MODEL), D_FF),
    }


def reference(x_prompt, x_sample, state_ret, cache_k, cache_v, norm_mix_pre, norm_mix_post,
              norm_ffn_pre, norm_ffn_post, ret_w_in, ret_w_out, kv_norm, w_kv, diff_w_q,
              diff_lambda, diff_g_sub, diff_w_out, mlp_w_up, mlp_w_down):
    weights = (norm_mix_pre, norm_mix_post, norm_ffn_pre, norm_ffn_post, ret_w_in, ret_w_out,
               kv_norm, w_kv, diff_w_q, diff_lambda, diff_g_sub, diff_w_out, mlp_w_up, mlp_w_down)
    b = x_prompt.shape[0]
    dt = x_prompt.dtype
    s0 = jnp.zeros((N_A_LAYERS, b, RET_HEADS, RET_DK, RET_DV), dt)
    k0 = jnp.zeros((b, 0, DIFF_HEADS, 2, DIFF_HD), dt)
    v0 = jnp.zeros((b, 0, DIFF_HEADS, 2 * DIFF_HD), dt)
    y_prompt, state_ret_prompt, k_prompt, v_prompt = trunk(x_prompt, s0, k0, v0, *weights)
    y_sample, state_ret_sample, k_sample, v_sample = trunk(x_sample, state_ret, cache_k, cache_v, *weights)
    return (y_prompt, y_sample, state_ret_prompt, k_prompt, v_prompt, state_ret_sample, k_sample, v_sample)
```

```cpp
#include <hip/hip_runtime.h>
#include <hip/hip_bf16.h>
#include <cstdio>
#include <cstdint>
#include <cmath>

#ifndef MK_PER_PHASE
#define MK_PER_PHASE 0
#endif

constexpr int DM = 2048, NBP = 4, SEQ = 4096, DB = 32, DS = 32, PAST = 1024;
constexpr int MP = NBP * SEQ, MS = DB * DS, MT = MP + MS;
constexpr int NH = 8, DK = 256, DV = 512, HD = 128, FF = 8192;
constexpr int SKV_S = 1152;
constexpr float EPS = 1e-6f;
namespace pg8 {
#define PG8_LAS __attribute__((address_space(3)))
typedef unsigned short bf16_t;
typedef short bf16x8 __attribute__((ext_vector_type(8)));
typedef float f32x4 __attribute__((ext_vector_type(4)));
typedef unsigned u32x4 __attribute__((ext_vector_type(4)));
constexpr int BM = 256, BK = 64, HALF = 128, HTB = HALF * BK * 2  , STAGE_BYTES = 8 * HTB, NXCD = 8, WGM = 4;

__host__ __device__ __forceinline__ int lds_byte(int r, int c) { const int st = (r >> 4) * 2 + (c >> 5), rr = r & 15, cc = c & 31, ob = rr * 64 + cc * 2; return st * 1024 + (ob ^ (((ob >> 9) & 1) << 5)); }
__host__ __device__ __forceinline__ void stage_rc(int b, int& R, int& C) { const int st = b / 1024, sb = b % 1024, swz = sb ^ (((sb >> 9) & 1) << 5); R = (st >> 1) * 16 + swz / 64; C = (st & 1) * 32 + (swz % 64) / 2; }
__host__ __device__ __forceinline__ int perm32(int rho) { const int n = rho >> 4, i = rho & 15; return 8 * (i >> 2) + 4 * n + (i & 3); }

struct Unit { int pm, pn; };
struct Gemm { const bf16_t* A; const bf16_t* Bt; int M, N, K, ld; int ldb = -1; };

struct StaticOrder {
    int nM, nN, nwg, G, c, wgm;
    __host__ __device__ void init(int M, int N, int G_, int c_, int wgm_ = WGM) { nM = M / BM; nN = N / BM; nwg = nM * nN; G = G_; c = c_; wgm = wgm_; }
    __host__ __device__ bool next(int i, Unit& u) const {
        const long L = (long)i * G + c; if (L >= nwg) return false;
        int wgid = (int)L; { const int q = nwg / NXCD, r = nwg % NXCD, xcd = wgid % NXCD, off = wgid / NXCD; wgid = (xcd < r ? xcd * (q + 1) : r * (q + 1) + (xcd - r) * q) + off; }
        const int nig = wgm * nN, gid = wgid / nig, fm = gid * wgm, gsz = (nM - fm) < wgm ? (nM - fm) : wgm;
        u.pm = fm + ((wgid % nig) % gsz); u.pn = (wgid % nig) / gsz; return true;
    }
    __device__ __forceinline__ void a_ready(const Unit&) const {}
    __device__ __forceinline__ void done(const Unit&) const {}
};

__device__ __forceinline__ unsigned cvt_pk_bf16(float lo, float hi) { unsigned r; asm volatile("v_cvt_pk_bf16_f32 %0, %1, %2" : "=v"(r) : "v"(lo), "v"(hi)); return r; }
typedef float f32x2 __attribute__((ext_vector_type(2)));
template <int ACT> struct EpiBf16Rs {
    static constexpr bool PERM = true, AFTER_DRAIN = false;
    bf16_t* O; int ldc; const float* rs;
    __device__ __forceinline__ void operator()(const f32x4 (&acc)[2][2][4][2], const Unit& u, int wr, int wc, int fr, int fq) const {
        const int row0 = u.pm * BM + wr * 64 + fr, col0 = u.pn * BM + wc * 32 + 8 * fq;
#pragma unroll
        for (int ai = 0; ai < 2; ++ai)
#pragma unroll
            for (int m = 0; m < 4; ++m) { const int row = row0 + ai * HALF + m * 16; const float s = rs[row]; bf16_t* rowp = O + (size_t)row * ldc + col0;
#pragma unroll
                for (int bj = 0; bj < 2; ++bj) { f32x4 v0 = acc[ai][bj][m][0] * s, v1 = acc[ai][bj][m][1] * s;
                    if (ACT == 1) { const f32x4 z = (f32x4){0.f, 0.f, 0.f, 0.f}; v0 = __builtin_elementwise_max(v0, z); v1 = __builtin_elementwise_max(v1, z); v0 = v0 * v0; v1 = v1 * v1; }
                    u32x4 w; w.x = cvt_pk_bf16(v0[0], v0[1]); w.y = cvt_pk_bf16(v0[2], v0[3]); w.z = cvt_pk_bf16(v1[0], v1[1]); w.w = cvt_pk_bf16(v1[2], v1[3]);
                    *(u32x4*)(rowp + bj * HALF) = w; } }
    }
};
struct EpiProj {
    static constexpr bool PERM = true, AFTER_DRAIN = false;
    bf16_t* O; const float* rs;
    __device__ __forceinline__ void operator()(const f32x4 (&acc)[2][2][4][2], const Unit& u, int wr, int wc, int fr, int fq) const {
        const int row0 = u.pm * BM + wr * 64 + fr, col0 = u.pn * BM + wc * 32 + 8 * fq;
        float lg = 0.f;
        if (u.pn < 16) { const int h = u.pn & 7; const float xg = __builtin_amdgcn_exp2f((float)(-5 - h));
            lg = -1.4426950408889634f * (xg * (1.f + xg * (0.5f + xg * (0.33333334f + xg * (0.25f + xg * 0.2f))))); if (u.pn >= 8) lg = -lg; }
#pragma unroll
        for (int ai = 0; ai < 2; ++ai)
#pragma unroll
            for (int m = 0; m < 4; ++m) { const int row = row0 + ai * HALF + m * 16; const int pos = row < 16384 ? (row & 63) : 32 + (row & 31);
                const float s = rs[row] * __builtin_amdgcn_exp2f(lg * (float)pos); bf16_t* rowp = O + (size_t)row * 12288 + col0;
#pragma unroll
                for (int bj = 0; bj < 2; ++bj) { const f32x4 v0 = acc[ai][bj][m][0] * s, v1 = acc[ai][bj][m][1] * s;
                    u32x4 w; w.x = cvt_pk_bf16(v0[0], v0[1]); w.y = cvt_pk_bf16(v0[2], v0[3]); w.z = cvt_pk_bf16(v1[0], v1[1]); w.w = cvt_pk_bf16(v1[2], v1[3]);
                    *(u32x4*)(rowp + bj * HALF) = w; } }
    }
};
struct EpiBf16Plain {
    static constexpr bool PERM = true, AFTER_DRAIN = false;
    bf16_t* O; int ldc;
    __device__ __forceinline__ void operator()(const f32x4 (&acc)[2][2][4][2], const Unit& u, int wr, int wc, int fr, int fq) const {
        const int row0 = u.pm * BM + wr * 64 + fr, col0 = u.pn * BM + wc * 32 + 8 * fq;
#pragma unroll
        for (int ai = 0; ai < 2; ++ai)
#pragma unroll
            for (int m = 0; m < 4; ++m) { bf16_t* rowp = O + (size_t)(row0 + ai * HALF + m * 16) * ldc + col0;
#pragma unroll
                for (int bj = 0; bj < 2; ++bj) { const f32x4 v0 = acc[ai][bj][m][0], v1 = acc[ai][bj][m][1];
                    u32x4 w; w.x = cvt_pk_bf16(v0[0], v0[1]); w.y = cvt_pk_bf16(v0[2], v0[3]); w.z = cvt_pk_bf16(v1[0], v1[1]); w.w = cvt_pk_bf16(v1[2], v1[3]);
                    *(u32x4*)(rowp + bj * HALF) = w; } }
    }
};
struct EpiF32 {
    static constexpr bool PERM = false, AFTER_DRAIN = false;
    float* C; int ldc;
    __device__ __forceinline__ void operator()(const f32x4 (&acc)[2][2][4][2], const Unit& u, int wr, int wc, int fr, int fq) const {
        const int row0 = u.pm * BM + wr * 64 + fr, col0 = u.pn * BM + wc * 32 + 4 * fq;
#pragma unroll
        for (int ai = 0; ai < 2; ++ai)
#pragma unroll
            for (int m = 0; m < 4; ++m) { float* rowp = C + (size_t)(row0 + ai * HALF + m * 16) * ldc + col0;
#pragma unroll
                for (int bj = 0; bj < 2; ++bj)
#pragma unroll
                    for (int n = 0; n < 2; ++n) *(f32x4*)(rowp + bj * HALF + n * 16) = acc[ai][bj][m][n]; }
    }
};
struct EpiKV {
    static constexpr bool PERM = true, AFTER_DRAIN = false;
    float* kP; float* vP; float* kS; float* vS; bf16_t* KpB; bf16_t* VpB; bf16_t* KsB; bf16_t* VsB; const float* rs; unsigned* kmax;
    __device__ __forceinline__ void operator()(const f32x4 (&acc)[2][2][4][2], const Unit& u, int wr, int wc, int fr, int fq) const {
        const int row0 = u.pm * BM + wr * 64 + fr; const int colt = u.pn * BM; const bool isV = colt >= 2048;
        const int col0 = (colt & 2047) + wc * 32 + 8 * fq; const bool prompt = u.pm < 64; const bool trackK = prompt && !isV; float nrm[2] = {0.f, 0.f};
#pragma unroll
        for (int ai = 0; ai < 2; ++ai)
#pragma unroll
            for (int m = 0; m < 4; ++m) { const int row = row0 + ai * HALF + m * 16; const float s = rs[row];
                float* fp; bf16_t* bp;
                if (prompt) { fp = (isV ? vP : kP) + (size_t)row * 2048 + col0; bp = (isV ? VpB : KpB) + (size_t)row * 2048 + col0; }
                else { const int rr = row - 16384; fp = (isV ? vS : kS) + (size_t)rr * 2048 + col0; bp = (isV ? VsB : KsB) + ((size_t)(rr >> 5) * 1152 + 1024 + (rr & 31)) * 2048 + col0; }
#pragma unroll
                for (int bj = 0; bj < 2; ++bj) { const f32x4 v0 = acc[ai][bj][m][0] * s, v1 = acc[ai][bj][m][1] * s;
                    *(f32x4*)(fp + bj * HALF) = v0; *(f32x4*)(fp + bj * HALF + 4) = v1;
                    u32x4 w; w.x = cvt_pk_bf16(v0[0], v0[1]); w.y = cvt_pk_bf16(v0[2], v0[3]); w.z = cvt_pk_bf16(v1[0], v1[1]); w.w = cvt_pk_bf16(v1[2], v1[3]);
                    *(u32x4*)(bp + bj * HALF) = w;
                    if (trackK) { const f32x4 q0 = v0 * v0, q1 = v1 * v1; nrm[bj] = fmaxf(nrm[bj], (q0[0] + q0[1]) + (q0[2] + q0[3]) + (q1[0] + q1[1]) + (q1[2] + q1[3])); } } }
        if (trackK) {
#pragma unroll
            for (int bj = 0; bj < 2; ++bj) { float v = nrm[bj];
                v = fmaxf(v, __int_as_float(__builtin_amdgcn_update_dpp(0, __float_as_int(v), 0xB1, 0xF, 0xF, true)));
                v = fmaxf(v, __int_as_float(__builtin_amdgcn_update_dpp(0, __float_as_int(v), 0x4E, 0xF, 0xF, true)));
                v = fmaxf(v, __int_as_float(__builtin_amdgcn_update_dpp(0, __float_as_int(v), 0x141, 0xF, 0xF, true)));
                v = fmaxf(v, __int_as_float(__builtin_amdgcn_update_dpp(0, __float_as_int(v), 0x140, 0xF, 0xF, true)));
                { auto rr = __builtin_amdgcn_permlane16_swap(__float_as_uint(v), __float_as_uint(v), false, false); v = __uint_as_float(rr[0]) + __uint_as_float(rr[1]); }
                { auto rr = __builtin_amdgcn_permlane32_swap(__float_as_uint(v), __float_as_uint(v), false, false); v = __uint_as_float(rr[0]) + __uint_as_float(rr[1]); }
                if (fr == 0 && fq == 0) atomicMax(kmax + (((u.pm >> 4) * 16 + u.pn * 2 + bj) * 4 + wc), __float_as_uint(v)); }
        }
    }
};

struct EpiKVQ {
    static constexpr bool PERM = true, AFTER_DRAIN = false;
    EpiKV kv; EpiBf16Rs<0> q;
    __device__ __forceinline__ void operator()(const f32x4 (&acc)[2][2][4][2], const Unit& u, int wr, int wc, int fr, int fq) const {
        if (u.pn < 16) kv(acc, u, wr, wc, fr, fq);
        else { Unit v = u; v.pn = u.pn - 16; q(acc, v, wr, wc, fr, fq); }
    }
};
struct SplitOrder {
    int G, c;
    __device__ __forceinline__ bool next(int i, Unit& u) const { const int item = c + i * G; if (item >= 256) return false; const int t = item >> 3; u.pm = t >> 3; u.pn = t & 7; return true; }
    __device__ __forceinline__ void a_ready(const Unit&) const {}
    __device__ __forceinline__ void done(const Unit&) const {}
};

template <class Epi, class Sched, bool ALIGN_EPI = false, bool SP2 = false>
__device__ __forceinline__ void gemm_phase(PG8_LAS unsigned char* lds, const Gemm g, const Sched& S, const Epi& E) {
    int tid = threadIdx.x; asm volatile("" : "+v"(tid));
    const int wid = __builtin_amdgcn_readfirstlane(tid >> 6), lane = tid & 63, wr = wid >> 2, wc = wid & 3, fr = lane & 15, fq = lane >> 4;
    const int K = g.K, nt = K / BK;
    const int ldb_ = g.ldb < 0 ? g.ld : g.ldb;
    unsigned voffA[2], voffB[2];
#pragma unroll
    for (int i = 0; i < 2; ++i) { int R, C; stage_rc(tid * 16 + i * 8192, R, C); const int Rb = Epi::PERM ? ((R & ~31) + perm32(R & 31)) : R;
        voffA[i] = (unsigned)(R * g.ld + C) * 2u; voffB[i] = (unsigned)(Rb * ldb_ + C) * 2u; }
    const size_t kstep = (size_t)(BK * 2);
    const size_t hstep = (size_t)HALF * g.ld * 2;
    const size_t tstep = 2 * hstep; const size_t hstepB = (size_t)HALF * ldb_ * 2, tstepB = 2 * hstepB;
    const unsigned ldsw = (unsigned)wid * 1024u;
    const int aoff = lds_byte(wr * 64 + fr, fq * 8), boff = lds_byte(wc * 32 + fr, fq * 8);
#define PG8_SA(b, h) (((b) * 2 + (h)) * HTB)
#define PG8_SB(b, h) ((4 + (b) * 2 + (h)) * HTB)
#define PG8_STAGE(bufoff, gbase, voff) do { _Pragma("unroll") for (int _i = 0; _i < 2; ++_i) \
        __builtin_amdgcn_global_load_lds((const unsigned*)((const char*)(gbase) + (voff)[_i]), (PG8_LAS unsigned*)(lds + (bufoff) + ldsw + _i * 8192), 16, 0, 0); } while (0)
#define PG8_LDA(dst, b, h) do { _Pragma("unroll") for (int m = 0; m < 4; ++m) _Pragma("unroll") for (int k = 0; k < 2; ++k) dst[m][k] = *(const PG8_LAS bf16x8*)(lds + PG8_SA(b, h) + aoff + m * 2048 + k * 1024); } while (0)
#define PG8_LDB(dst, b, h) do { _Pragma("unroll") for (int n = 0; n < 2; ++n) _Pragma("unroll") for (int k = 0; k < 2; ++k) dst[n][k] = *(const PG8_LAS bf16x8*)(lds + PG8_SB(b, h) + boff + n * 2048 + k * 1024); } while (0)
#define PG8_MMA(ai, bj, At, Bt) do { __builtin_amdgcn_s_setprio(1); _Pragma("unroll") for (int m = 0; m < 4; ++m) _Pragma("unroll") for (int n = 0; n < 2; ++n) _Pragma("unroll") for (int k = 0; k < 2; ++k) \
        acc[ai][bj][m][n] = __builtin_amdgcn_mfma_f32_16x16x32_bf16(Bt[n][k], At[m][k], acc[ai][bj][m][n], 0, 0, 0); __builtin_amdgcn_s_setprio(0); } while (0)
#define PG8_WAIT_V(n) asm volatile("s_waitcnt vmcnt(" #n ")" ::: "memory")
#define PG8_WAIT_L(n) asm volatile("s_waitcnt lgkmcnt(" #n ")" ::: "memory")
#define PG8_BAR __builtin_amdgcn_s_barrier()
#define PG8_SCHED __builtin_amdgcn_sched_barrier(0)
    Unit cur, nxt; int ui = 0;
    if (!S.next(0, cur)) return;
    f32x4 acc[2][2][4][2];
#pragma unroll
    for (int a = 0; a < 2; ++a)
#pragma unroll
        for (int b = 0; b < 2; ++b)
#pragma unroll
            for (int m = 0; m < 4; ++m)
#pragma unroll
                for (int n = 0; n < 2; ++n) acc[a][b][m][n] = (f32x4){0.f, 0.f, 0.f, 0.f};
    bf16x8 At[4][2], B0[2][2], B1[2][2];
    const char* cA = (const char*)g.A + (size_t)cur.pm * tstep; const char* cB = (const char*)g.Bt + (size_t)cur.pn * tstepB;
    S.a_ready(cur);
    if constexpr (SP2) {
        PG8_STAGE(PG8_SB(0, 0), cB, voffB); PG8_STAGE(PG8_SB(0, 1), cB + hstepB, voffB); PG8_STAGE(PG8_SA(0, 0), cA, voffA); PG8_STAGE(PG8_SA(0, 1), cA + hstep, voffA);
        if (wr == 1) PG8_BAR;
        PG8_WAIT_V(2); PG8_BAR;
        PG8_STAGE(PG8_SB(1, 0), cB + kstep, voffB); PG8_STAGE(PG8_SA(1, 0), cA + kstep, voffA); PG8_STAGE(PG8_SB(1, 1), cB + hstepB + kstep, voffB);
        PG8_WAIT_V(6); PG8_BAR;
    } else {
        PG8_STAGE(PG8_SB(0, 0), cB, voffB); PG8_STAGE(PG8_SA(0, 0), cA, voffA); PG8_STAGE(PG8_SB(0, 1), cB + hstepB, voffB); PG8_STAGE(PG8_SA(0, 1), cA + hstep, voffA);
        if (wr == 1) PG8_BAR;
        PG8_WAIT_V(4); PG8_BAR;
        PG8_STAGE(PG8_SB(1, 0), cB + kstep, voffB); PG8_STAGE(PG8_SA(1, 0), cA + kstep, voffA); PG8_STAGE(PG8_SB(1, 1), cB + hstepB + kstep, voffB);
        PG8_WAIT_V(6); PG8_BAR;
    }
    for (;;) {
        const bool has_next = S.next(ui + 1, nxt);
        const char* nA = has_next ? (const char*)g.A + (size_t)nxt.pm * tstep : cA; const char* nB = has_next ? (const char*)g.Bt + (size_t)nxt.pn * tstepB : cB;
        for (int t = 0; t < nt; t += 2) {
            const bool last = (t == nt - 2);
            const char* a1 = cA + (size_t)(t + 1) * kstep;
            const char* a2 = last ? nA : cA + (size_t)(t + 2) * kstep; const char* b2 = last ? nB : cB + (size_t)(t + 2) * kstep;
            const char* a3 = a2 + kstep; const char* b3 = b2 + kstep;
            if (last && has_next) S.a_ready(nxt);
            if constexpr (SP2) {
            PG8_LDB(B0, 0, 0); PG8_LDB(B1, 0, 1); PG8_SCHED; PG8_LDA(At, 0, 0); PG8_STAGE(PG8_SA(1, 1), a1 + hstep, voffA);
            PG8_WAIT_V(8); PG8_WAIT_L(0); PG8_BAR; PG8_MMA(0, 0, At, B0); PG8_MMA(0, 1, At, B1); PG8_BAR; PG8_SCHED;
            PG8_LDA(At, 0, 1); PG8_STAGE(PG8_SB(0, 0), b2, voffB); PG8_STAGE(PG8_SB(0, 1), b2 + hstepB, voffB); PG8_STAGE(PG8_SA(0, 0), a2, voffA);
            PG8_WAIT_V(8); PG8_WAIT_L(0); PG8_BAR; PG8_MMA(1, 0, At, B0); PG8_MMA(1, 1, At, B1); PG8_BAR; PG8_SCHED;
            PG8_LDB(B0, 1, 0); PG8_LDB(B1, 1, 1); PG8_SCHED; PG8_LDA(At, 1, 0); PG8_STAGE(PG8_SA(0, 1), a2 + hstep, voffA);
            PG8_WAIT_V(8); PG8_WAIT_L(0); PG8_BAR; PG8_MMA(0, 0, At, B0); PG8_MMA(0, 1, At, B1); PG8_BAR; PG8_SCHED;
            PG8_LDA(At, 1, 1); PG8_STAGE(PG8_SB(1, 0), b3, voffB); PG8_STAGE(PG8_SB(1, 1), b3 + hstepB, voffB); PG8_STAGE(PG8_SA(1, 0), a3, voffA);
            PG8_WAIT_V(8); PG8_WAIT_L(0); PG8_BAR; PG8_MMA(1, 0, At, B0); PG8_MMA(1, 1, At, B1); PG8_BAR; PG8_SCHED;
            } else {
            PG8_LDB(B0, 0, 0); PG8_SCHED; PG8_LDA(At, 0, 0); PG8_STAGE(PG8_SA(1, 1), a1 + hstep, voffA);
            PG8_WAIT_L(8); PG8_BAR; PG8_WAIT_L(0); PG8_MMA(0, 0, At, B0); PG8_BAR; PG8_SCHED;
            PG8_LDB(B1, 0, 1); PG8_STAGE(PG8_SB(0, 0), b2, voffB);
            PG8_BAR; PG8_WAIT_L(0); PG8_MMA(0, 1, At, B1); PG8_BAR;
            PG8_LDA(At, 0, 1); PG8_STAGE(PG8_SA(0, 0), a2, voffA);
            PG8_BAR; PG8_WAIT_L(0); PG8_MMA(1, 0, At, B0); PG8_BAR; PG8_SCHED;
            PG8_STAGE(PG8_SB(0, 1), b2 + hstepB, voffB);
            PG8_WAIT_V(6); PG8_BAR; PG8_MMA(1, 1, At, B1); PG8_BAR;
            PG8_LDB(B0, 1, 0); PG8_SCHED; PG8_LDA(At, 1, 0); PG8_STAGE(PG8_SA(0, 1), a2 + hstep, voffA);
            PG8_WAIT_L(8); PG8_BAR; PG8_WAIT_L(0); PG8_MMA(0, 0, At, B0); PG8_BAR; PG8_SCHED;
            PG8_LDB(B1, 1, 1); PG8_STAGE(PG8_SB(1, 0), b3, voffB);
            PG8_BAR; PG8_WAIT_L(0); PG8_MMA(0, 1, At, B1); PG8_BAR;
            PG8_LDA(At, 1, 1); PG8_STAGE(PG8_SA(1, 0), a3, voffA);
            PG8_BAR; PG8_WAIT_L(0); PG8_MMA(1, 0, At, B0); PG8_BAR; PG8_SCHED;
            PG8_STAGE(PG8_SB(1, 1), b3 + hstepB, voffB);
            PG8_WAIT_V(6); PG8_BAR; PG8_MMA(1, 1, At, B1); PG8_BAR;
            }
        }
        if constexpr (ALIGN_EPI) { if (wr == 0) PG8_BAR; }
        if constexpr (!Epi::AFTER_DRAIN) { E(acc, cur, wr, wc, fr, fq); S.done(cur); }
        if (!has_next) break;
#pragma unroll
        for (int a = 0; a < 2; ++a)
#pragma unroll
            for (int b = 0; b < 2; ++b)
#pragma unroll
                for (int m = 0; m < 4; ++m)
#pragma unroll
                    for (int n = 0; n < 2; ++n) acc[a][b][m][n] = (f32x4){0.f, 0.f, 0.f, 0.f};
        cur = nxt; cA = nA; cB = nB; ++ui;
        if constexpr (ALIGN_EPI) { if (wr == 1) PG8_BAR; }
    }
    PG8_WAIT_V(0);
    if constexpr (!ALIGN_EPI) { if (wr == 0) PG8_BAR; }
    PG8_BAR;
    if constexpr (Epi::AFTER_DRAIN) { E.fused(acc, cur, wr, wc, fr, fq, lds, wid, lane); S.done(cur); }
#undef PG8_SA
#undef PG8_SB
#undef PG8_STAGE
#undef PG8_LDA
#undef PG8_LDB
#undef PG8_MMA
#undef PG8_WAIT_V
#undef PG8_WAIT_L
#undef PG8_BAR
#undef PG8_SCHED
}
}
constexpr size_t WS_CTL = 0, CTL_ZERO_BYTES = 1u << 20;
constexpr size_t SZ_WIN = (size_t)DM * 6 * DM * 2, SZ_WRO = (size_t)2 * DM * DM * 2, SZ_WUP = (size_t)DM * FF * 2, SZ_WDN = SZ_WUP, SZ_WKV = (size_t)DM * 2 * DM * 2, SZ_WQ = (size_t)DM * DM * 2;
constexpr size_t WS_WIN = CTL_ZERO_BYTES, WS_WRO = WS_WIN + 2 * SZ_WIN, WS_WUP = WS_WRO + 2 * SZ_WRO, WS_WDN = WS_WUP + 4 * SZ_WUP, WS_WKV = WS_WDN + 4 * SZ_WDN,
                 WS_WQ = WS_WKV + SZ_WKV, WS_WO = WS_WQ + 2 * SZ_WQ;
constexpr size_t WS_XB = WS_WO + 2 * SZ_WQ;
constexpr size_t WS_RS = WS_XB + (size_t)MT * DM * 2;
constexpr size_t WS_M = WS_RS + (size_t)MT * 4;
constexpr size_t WS_R1 = WS_M + (size_t)MT * DM * 4;
constexpr size_t WS_R2 = WS_R1 + (size_t)MT * 6 * DM * 2;
constexpr size_t WS_R3 = WS_R2 + (size_t)MT * 2 * DM * 2;
constexpr size_t WS_KP = WS_R3 + (size_t)MT * 2 * DM * 2;
constexpr size_t WS_VP = WS_KP + (size_t)MP * DM * 2, WS_KS = WS_VP + (size_t)MP * DM * 2, WS_VS = WS_KS + (size_t)DB * SKV_S * DM * 2;
constexpr size_t WS_END = WS_VS + (size_t)DB * SKV_S * DM * 2;
constexpr int CW_KMAX = 1024;
constexpr int CW_ATTQ = 2048;
constexpr int CW_BAR = 4096;
constexpr size_t OUT_Y = 0, OUT_SP = (size_t)MT * DM, SZ_ST = (size_t)NH * DK * DV, OUT_KP = OUT_SP + (size_t)2 * NBP * SZ_ST, OUT_VP = OUT_KP + (size_t)MP * DM,
                 OUT_SS = OUT_VP + (size_t)MP * DM, OUT_KS = OUT_SS + (size_t)2 * DB * SZ_ST, OUT_VS = OUT_KS + (size_t)MS * DM, OUT_END = OUT_VS + (size_t)MS * DM;

constexpr int LDS_MAIN = 161792;
constexpr int MISC_OFF = LDS_MAIN, LDS_BYTES = LDS_MAIN + 512;

#define GAS __attribute__((address_space(1)))
#define LAS __attribute__((address_space(3)))
typedef unsigned short bf16;
typedef unsigned v4u __attribute__((ext_vector_type(4)));
typedef unsigned v2u __attribute__((ext_vector_type(2)));
typedef float f32x4 __attribute__((ext_vector_type(4)));
typedef float f32x16 __attribute__((ext_vector_type(16)));
typedef short bf16x8 __attribute__((ext_vector_type(8)));
typedef short s16x4 __attribute__((ext_vector_type(4)));
__device__ __forceinline__ unsigned pk2(float lo, float hi) { unsigned r; asm volatile("v_cvt_pk_bf16_f32 %0, %1, %2" : "=v"(r) : "v"(lo), "v"(hi)); return r; }
__device__ __forceinline__ float bflo(unsigned w) { return __uint_as_float(w << 16); }
__device__ __forceinline__ float bfhi(unsigned w) { return __uint_as_float(w & 0xffff0000u); }
__device__ __forceinline__ float wave_sum(float v) {
    v += __int_as_float(__builtin_amdgcn_update_dpp(0, __float_as_int(v), 0xB1, 0xF, 0xF, true));
    v += __int_as_float(__builtin_amdgcn_update_dpp(0, __float_as_int(v), 0x4E, 0xF, 0xF, true));
    v += __int_as_float(__builtin_amdgcn_update_dpp(0, __float_as_int(v), 0x141, 0xF, 0xF, true));
    v += __int_as_float(__builtin_amdgcn_update_dpp(0, __float_as_int(v), 0x140, 0xF, 0xF, true));
    { auto rr = __builtin_amdgcn_permlane16_swap(__float_as_uint(v), __float_as_uint(v), false, false); v = __uint_as_float(rr[0]) + __uint_as_float(rr[1]); }
    { auto rr = __builtin_amdgcn_permlane32_swap(__float_as_uint(v), __float_as_uint(v), false, false); v = __uint_as_float(rr[0]) + __uint_as_float(rr[1]); }
    return v;
}
__device__ __forceinline__ int crow(int r, int hi) { return (r & 3) + 8 * (r >> 2) + 4 * hi; }

template <int OFF> __device__ __forceinline__ bf16x8 lds_rd128(int a) { bf16x8 r; asm volatile("ds_read_b128 %0, %1 offset:%2" : "=&v"(r) : "v"(a), "i"(OFF) : "memory"); return r; }
template <int OFF> __device__ __forceinline__ s16x4 lds_tr64(int a) { s16x4 r; asm volatile("ds_read_b64_tr_b16 %0, %1 offset:%2" : "=&v"(r) : "v"(a), "i"(OFF) : "memory"); return r; }
#define LDS_WAIT_SB(n) do { asm volatile("s_waitcnt lgkmcnt(" #n ")" ::: "memory"); __builtin_amdgcn_sched_barrier(0); } while (0)

#define XB_TMO      128
#define XB_XCNT(j)  (256  + 64 * (j))
#define XB_XSUB(j)  (1280 + 64 * (j))
#define XB_XGEN(j)  (2304 + 64 * (j))
#define XB_TOP      3328
#define XB_TOPGEN   3392
#define XCD_BAR_WORDS 3456
#define XB_SPIN_CAP (1u << 18)

__device__ __forceinline__ unsigned xb_ld(unsigned* p)              { return __hip_atomic_load(p, __ATOMIC_RELAXED, __HIP_MEMORY_SCOPE_AGENT); }
__device__ __forceinline__ unsigned xb_add(unsigned* p, unsigned v) { return __hip_atomic_fetch_add(p, v, __ATOMIC_RELAXED, __HIP_MEMORY_SCOPE_AGENT); }
__device__ __forceinline__ unsigned xb_xcc_id() { return (unsigned)__builtin_amdgcn_s_getreg((3 << 11) | 20) & 0xFu; }
#define XB_SPIN(cond, bar) do { unsigned _sp = 0; while (cond) { __builtin_amdgcn_s_sleep(1); \
    if ((++_sp & 255u) == 0u) { if (xb_ld(&(bar)[XB_TMO])) break; if (_sp > XB_SPIN_CAP) { atomicAdd(&(bar)[XB_TMO], 1u); break; } } } } while (0)

struct XcdBarrier {
    unsigned* bar; unsigned x;
    volatile LAS unsigned* st;
};

__device__ __forceinline__ XcdBarrier xcd_barrier_post(unsigned* bar, volatile LAS unsigned* st) {
    XcdBarrier b; b.bar = bar; b.x = xb_xcc_id(); b.st = st;
    if (threadIdx.x == 0) (void)xb_add(&bar[XB_XCNT(b.x)], 1u);
    return b;
}
__device__ __forceinline__ void xcd_barrier_complete(unsigned* bar, unsigned x, unsigned& nloc, unsigned& nx) {
    const unsigned G = gridDim.x * gridDim.y * gridDim.z;
    unsigned sum, cnt, mine, sp = 0u;
    for (;;) {
        sum = 0u; cnt = 0u; mine = 0u;
#pragma unroll
        for (unsigned j = 0; j < 16; ++j) { const unsigned c = xb_ld(&bar[XB_XCNT(j)]); sum += c; cnt += (c > 0u) ? 1u : 0u; mine = (j == x) ? c : mine; }
        if (sum == G) break;
        __builtin_amdgcn_s_sleep(1);
        if ((++sp & 255u) == 0u) { if (xb_ld(&bar[XB_TMO])) break; if (sp > XB_SPIN_CAP) { atomicAdd(&bar[XB_TMO], 1u); break; } }
    }
    nloc = mine > 0u ? mine : 1u; nx = cnt > 0u ? cnt : 1u;
}

__device__ __forceinline__ void xcd_barrier(const XcdBarrier& b) {
    asm volatile("s_waitcnt vmcnt(0)" ::: "memory");
    __syncthreads();
    if (threadIdx.x == 0) {
        unsigned* bar = b.bar;
        __builtin_amdgcn_s_waitcnt(0);
        unsigned nloc = b.st[0], nx = b.st[1];
        if (nloc == 0u) { xcd_barrier_complete(bar, b.x, nloc, nx); b.st[0] = nloc; b.st[1] = nx; }
        const unsigned old = xb_add(&bar[XB_XSUB(b.x)], 1u);
        const unsigned gen = old / nloc;
        if (old + 1u == (gen + 1u) * nloc) {
            __builtin_amdgcn_fence(__ATOMIC_RELEASE, "agent");
            asm volatile("s_waitcnt vmcnt(0)" ::: "memory");
            const unsigned og = xb_add(&bar[XB_TOP], 1u);
            const unsigned tg = og / nx;
            if (og + 1u == (tg + 1u) * nx) xb_add(&bar[XB_TOPGEN], 1u);
            else XB_SPIN(xb_ld(&bar[XB_TOPGEN]) == tg, bar);
            __builtin_amdgcn_fence(__ATOMIC_ACQUIRE, "agent");
            xb_add(&bar[XB_XGEN(b.x)], 1u);
            asm volatile("s_waitcnt vmcnt(0)" ::: "memory");
        } else {
            XB_SPIN(xb_ld(&bar[XB_XGEN(b.x)]) == gen, bar);
            __builtin_amdgcn_fence(__ATOMIC_ACQUIRE, "agent");
            asm volatile("s_waitcnt vmcnt(0)" ::: "memory");
        }
    }
    __syncthreads();
}
__device__ __forceinline__ void tr_matrix(const float* __restrict__ W, int K, int N, bf16* __restrict__ WT, const float* __restrict__ gk, int gmask, float gscale,
                                          int cs_lo, int cs_hi, float cs, LAS float* scr, int gw, int ngw, int lane) {
    const int nblk = N / 64, nitems = (K / 64) * nblk;
    for (int it = gw; it < nitems; it += ngw) {
        const int kb = it / nblk, nb = it - kb * nblk, k0 = 64 * kb, n0 = 64 * nb;
        const float csf = (n0 >= cs_lo && n0 < cs_hi) ? cs * gscale : gscale;
        const int r4 = lane >> 4, c4 = (lane & 15) * 4;
#pragma unroll
        for (int half = 0; half < 2; ++half) {
            f32x4 v[8]; float g[8];
#pragma unroll
            for (int i = 0; i < 8; ++i) { const int kk = (half * 8 + i) * 4 + r4; v[i] = *(const f32x4*)(W + (size_t)(k0 + kk) * N + n0 + c4); g[i] = gk ? gk[(k0 + kk) & gmask] * csf : csf; }
#pragma unroll
            for (int i = 0; i < 8; ++i) { const int kk = (half * 8 + i) * 4 + r4; *(LAS f32x4*)(scr + kk * 68 + c4) = v[i] * g[i]; }
        }
        asm volatile("s_waitcnt lgkmcnt(0)" ::: "memory");
        bf16* orow = WT + (size_t)(n0 + lane) * K + k0;
#pragma unroll
        for (int c = 0; c < 8; ++c) { v4u o;
            o.x = pk2(scr[(8 * c + 0) * 68 + lane], scr[(8 * c + 1) * 68 + lane]); o.y = pk2(scr[(8 * c + 2) * 68 + lane], scr[(8 * c + 3) * 68 + lane]);
            o.z = pk2(scr[(8 * c + 4) * 68 + lane], scr[(8 * c + 5) * 68 + lane]); o.w = pk2(scr[(8 * c + 6) * 68 + lane], scr[(8 * c + 7) * 68 + lane]);
            *(v4u*)(orow + 8 * c) = o; }
        asm volatile("s_waitcnt lgkmcnt(0)" ::: "memory");
    }
}
__device__ __forceinline__ void cvt_row(const float* __restrict__ src, bf16* __restrict__ dst, int lane) {
    const f32x4* s = (const f32x4*)src + lane; v2u* d = (v2u*)dst + lane;
#pragma unroll
    for (int j = 0; j < 8; ++j) { const f32x4 v = s[64 * j]; v2u o; o.x = pk2(v.x, v.y); o.y = pk2(v.z, v.w); d[64 * j] = o; }
}
__device__ __forceinline__ void x_init_row(const float* __restrict__ src, bf16* __restrict__ xb, float* __restrict__ rs, int lane) {
    const f32x4* s = (const f32x4*)src + lane; v2u* d = (v2u*)xb + lane; float ss = 0.f;
#pragma unroll
    for (int j = 0; j < 8; ++j) { const f32x4 v = s[64 * j]; ss += (v.x * v.x + v.y * v.y) + (v.z * v.z + v.w * v.w); v2u o; o.x = pk2(v.x, v.y); o.y = pk2(v.z, v.w); d[64 * j] = o; }
    ss = wave_sum(ss);
    if (lane == 0) *rs = 1.0f / sqrtf(ss * (1.0f / DM) + EPS);
}
__device__ __forceinline__ void res_row(bf16* __restrict__ xb, const bf16* __restrict__ mb, const float* __restrict__ ms, const float (&gv)[4][8], float* __restrict__ rs, float* __restrict__ y, int lane) {
    float mv[4][8]; float sm = 0.f;
    if (mb) {
#pragma unroll
        for (int j = 0; j < 4; ++j) { const v4u w = *((const v4u*)mb + lane + 64 * j);
            mv[j][0] = bflo(w.x); mv[j][1] = bfhi(w.x); mv[j][2] = bflo(w.y); mv[j][3] = bfhi(w.y); mv[j][4] = bflo(w.z); mv[j][5] = bfhi(w.z); mv[j][6] = bflo(w.w); mv[j][7] = bfhi(w.w); }
    } else {
#pragma unroll
        for (int j = 0; j < 4; ++j) { const f32x4* p = (const f32x4*)ms + 2 * (lane + 64 * j); f32x4 a[8], b[8];
#pragma unroll
            for (int sl = 0; sl < 8; ++sl) { a[sl] = p[(size_t)sl * (MS * DM / 4)]; b[sl] = p[(size_t)sl * (MS * DM / 4) + 1]; }
            const f32x4 as = ((a[0] + a[1]) + (a[2] + a[3])) + ((a[4] + a[5]) + (a[6] + a[7])), bs = ((b[0] + b[1]) + (b[2] + b[3])) + ((b[4] + b[5]) + (b[6] + b[7]));
            mv[j][0] = as.x; mv[j][1] = as.y; mv[j][2] = as.z; mv[j][3] = as.w; mv[j][4] = bs.x; mv[j][5] = bs.y; mv[j][6] = bs.z; mv[j][7] = bs.w; }
    }
#pragma unroll
    for (int j = 0; j < 4; ++j)
#pragma unroll
        for (int e = 0; e < 8; ++e) sm += mv[j][e] * mv[j][e];
    sm = wave_sum(sm);
    const float rm = 1.0f / sqrtf(sm * (1.0f / DM) + EPS); float sx = 0.f;
#pragma unroll
    for (int j = 0; j < 4; ++j) { const int c = lane + 64 * j; const v4u xw = *((const v4u*)xb + c);
        float xv[8] = {bflo(xw.x), bfhi(xw.x), bflo(xw.y), bfhi(xw.y), bflo(xw.z), bfhi(xw.z), bflo(xw.w), bfhi(xw.w)};
#pragma unroll
        for (int e = 0; e < 8; ++e) { xv[e] = xv[e] + mv[j][e] * gv[j][e] * rm; }
        v4u o; o.x = pk2(xv[0], xv[1]); o.y = pk2(xv[2], xv[3]); o.z = pk2(xv[4], xv[5]); o.w = pk2(xv[6], xv[7]);
        *((v4u*)xb + c) = o;
        if (y) { *((f32x4*)y + 2 * c) = (f32x4){xv[0], xv[1], xv[2], xv[3]}; *((f32x4*)y + 2 * c + 1) = (f32x4){xv[4], xv[5], xv[6], xv[7]}; }
        const float r0 = bflo(o.x), r1 = bfhi(o.x), r2 = bflo(o.y), r3 = bfhi(o.y), r4 = bflo(o.z), r5 = bfhi(o.z), r6 = bflo(o.w), r7 = bfhi(o.w);
        sx += (r0 * r0 + r1 * r1) + (r2 * r2 + r3 * r3) + (r4 * r4 + r5 * r5) + (r6 * r6 + r7 * r7); }
    sx = wave_sum(sx);
    if (lane == 0) *rs = 1.0f / sqrtf(sx * (1.0f / DM) + EPS);
}
__device__ __forceinline__ void load_gains(float (&gv)[4][8], const float* __restrict__ gpost, int lane) {
#pragma unroll
    for (int j = 0; j < 4; ++j) { const int c = lane + 64 * j; const f32x4 g0 = *((const f32x4*)gpost + 2 * c), g1 = *((const f32x4*)gpost + 2 * c + 1);
        gv[j][0] = g0.x; gv[j][1] = g0.y; gv[j][2] = g0.z; gv[j][3] = g0.w; gv[j][4] = g1.x; gv[j][5] = g1.y; gv[j][6] = g1.z; gv[j][7] = g1.w; }
}
__device__ __forceinline__ void gate_item(const bf16* __restrict__ o, const bf16* __restrict__ g, bf16* __restrict__ og, int lane) {
    const v4u ov = *((const v4u*)o + lane), gv = *((const v4u*)g + lane);
    float of[8] = {bflo(ov.x), bfhi(ov.x), bflo(ov.y), bfhi(ov.y), bflo(ov.z), bfhi(ov.z), bflo(ov.w), bfhi(ov.w)};
    float gf[8] = {bflo(gv.x), bfhi(gv.x), bflo(gv.y), bfhi(gv.y), bflo(gv.z), bfhi(gv.z), bflo(gv.w), bfhi(gv.w)};
    float ss = 0.f;
#pragma unroll
    for (int i = 0; i < 8; ++i) ss += of[i] * of[i];
    ss = wave_sum(ss);
    const float r = 1.0f / sqrtf(ss * (1.0f / DV) + EPS);
#pragma unroll
    for (int i = 0; i < 8; ++i) { const float s = gf[i] / (1.0f + __expf(-gf[i])); of[i] = s * of[i] * r; }
    v4u w; w.x = pk2(of[0], of[1]); w.y = pk2(of[2], of[3]); w.z = pk2(of[4], of[5]); w.w = pk2(of[6], of[7]);
    *((v4u*)og + lane) = w;
}
__device__ __forceinline__ void comb_item(const bf16* __restrict__ ao, bf16* __restrict__ oa, float lam, int lane) {
    const int vhalf = lane >> 5, e = (lane & 31) * 4;
    const v2u a = *(const v2u*)(ao + vhalf * 128 + e), b = *(const v2u*)(ao + (2 + vhalf) * 128 + e);
    float v[4] = {bflo(a.x) - lam * bflo(b.x), bfhi(a.x) - lam * bfhi(b.x), bflo(a.y) - lam * bflo(b.y), bfhi(a.y) - lam * bfhi(b.y)};
    float ss = (v[0] * v[0] + v[1] * v[1]) + (v[2] * v[2] + v[3] * v[3]);
    ss = wave_sum(ss);
    const float r = 1.0f / sqrtf(ss * (1.0f / 256.0f) + EPS);
    v2u w; w.x = pk2(v[0] * r, v[1] * r); w.y = pk2(v[2] * r, v[3] * r);
    *(v2u*)(oa + vhalf * 128 + e) = w;
}

template <int NB>
__device__ __forceinline__ void gate_items(const bf16* const (&o)[NB], const bf16* const (&g)[NB], bf16* const (&og)[NB], int lane) {
    v4u ov[NB], gv[NB];
#pragma unroll
    for (int n = 0; n < NB; ++n) { ov[n] = *((const v4u*)o[n] + lane); gv[n] = *((const v4u*)g[n] + lane); }
#pragma unroll
    for (int n = 0; n < NB; ++n) {
        float of[8] = {bflo(ov[n].x), bfhi(ov[n].x), bflo(ov[n].y), bfhi(ov[n].y), bflo(ov[n].z), bfhi(ov[n].z), bflo(ov[n].w), bfhi(ov[n].w)};
        float gf[8] = {bflo(gv[n].x), bfhi(gv[n].x), bflo(gv[n].y), bfhi(gv[n].y), bflo(gv[n].z), bfhi(gv[n].z), bflo(gv[n].w), bfhi(gv[n].w)};
        float ss = 0.f;
#pragma unroll
        for (int i = 0; i < 8; ++i) ss += of[i] * of[i];
        ss = wave_sum(ss);
        const float r = 1.0f / sqrtf(ss * (1.0f / DV) + EPS);
#pragma unroll
        for (int i = 0; i < 8; ++i) { const float s = gf[i] * __builtin_amdgcn_rcpf(1.0f + __builtin_amdgcn_exp2f(gf[i] * -1.4426950408889634f)); of[i] = s * of[i] * r; }
        v4u w; w.x = pk2(of[0], of[1]); w.y = pk2(of[2], of[3]); w.z = pk2(of[4], of[5]); w.w = pk2(of[6], of[7]);
        *((v4u*)og[n] + lane) = w; }
}
template <int NB>
__device__ __forceinline__ void comb_items(const bf16* const (&ao)[NB], bf16* const (&oa)[NB], float lam, int lane) {
    const int vhalf = lane >> 5, e = (lane & 31) * 4;
    v2u a[NB], b[NB];
#pragma unroll
    for (int n = 0; n < NB; ++n) { a[n] = *(const v2u*)(ao[n] + vhalf * 128 + e); b[n] = *(const v2u*)(ao[n] + (2 + vhalf) * 128 + e); }
#pragma unroll
    for (int n = 0; n < NB; ++n) {
        float v[4] = {bflo(a[n].x) - lam * bflo(b[n].x), bfhi(a[n].x) - lam * bfhi(b[n].x), bflo(a[n].y) - lam * bflo(b[n].y), bfhi(a[n].y) - lam * bfhi(b[n].y)};
        float ss = (v[0] * v[0] + v[1] * v[1]) + (v[2] * v[2] + v[3] * v[3]);
        ss = wave_sum(ss);
        const float r = 1.0f / sqrtf(ss * (1.0f / 256.0f) + EPS);
        v2u w; w.x = pk2(v[0] * r, v[1] * r); w.y = pk2(v[2] * r, v[3] * r);
        *(v2u*)(oa[n] + vhalf * 128 + e) = w; }
}

namespace ret {
constexpr int QK_STRIDE = 528;
constexpr int Q_OFF = 0, K_OFF = 64 * QK_STRIDE, V_OFF = 2 * 64 * QK_STRIDE, VD_OFF = V_OFF + 8192, S_OFF = VD_OFF + 8192;
static_assert(S_OFF + 65536 <= LDS_MAIN, "retention LDS map");
__device__ __forceinline__ int v_off(int row, int ch) { return row * 128 + ((ch ^ ((row & 2) << 1)) << 4); }
typedef short v4i16_t __attribute__((ext_vector_type(4)));
__device__ __forceinline__ s16x4 vtr(const LAS unsigned char* p) { return __builtin_bit_cast(s16x4, __builtin_amdgcn_ds_read_tr16_b64_v4i16((LAS v4i16_t*)p)); }
__device__ __forceinline__ int vbase(int lane, int nq) {
    const int i = lane & 15, q = i >> 2, p = i & 3, h = lane >> 5, cg = (lane >> 4) & 1, fq = (q >> 1) & 1;
    return (8 * h + q) * 128 + ((4 * (nq ^ fq) + 2 * cg + (p >> 1)) << 4) + (p & 1) * 8;
}
__device__ __forceinline__ bf16x8 tr_frag_v(const LAS unsigned char* img, int vb, int kb) {
    const s16x4 lo = vtr(img + vb + kb * 128), hi = vtr(img + vb + kb * 128 + 512);
    return (bf16x8){lo[0], lo[1], lo[2], lo[3], hi[0], hi[1], hi[2], hi[3]};
}
__device__ __forceinline__ int kbase(int lane) {
    const int i = lane & 15, q = i >> 2, p = i & 3, h = lane >> 5, cg = (lane >> 4) & 1;
    return (8 * h + q) * QK_STRIDE + (16 * cg + 4 * p) * 2;
}
__device__ __forceinline__ bf16x8 tr_frag_k(const LAS unsigned char* img, int kbs, int kb, int nb) {
    const s16x4 lo = vtr(img + kbs + kb * QK_STRIDE + nb * 2), hi = vtr(img + kbs + (kb + 4) * QK_STRIDE + nb * 2);
    return (bf16x8){lo[0], lo[1], lo[2], lo[3], hi[0], hi[1], hi[2], hi[3]};
}
__device__ __forceinline__ int rbase(int lane) { return (lane & 31) * QK_STRIDE + (lane >> 5) * 16; }
__device__ __forceinline__ bf16x8 row_frag(const LAS unsigned char* img, int rbs, int rb, int kb) {
    return *(const LAS bf16x8*)(img + rbs + rb * QK_STRIDE + kb * 2);
}

#define TRPK(lo, hi) (bf16x8){lo[0], lo[1], lo[2], lo[3], hi[0], hi[1], hi[2], hi[3]}
template <int D0> __device__ __forceinline__ void sc_load(bf16x8 (&f)[12], int qa, int ka) {
#pragma unroll
    for (int i = 0; i < 4; ++i) { }
    f[0] = lds_rd128<(D0 + 0) * 32>(qa); f[1] = lds_rd128<(D0 + 0) * 32>(ka); f[2] = lds_rd128<32 * QK_STRIDE + (D0 + 0) * 32>(ka);
    f[3] = lds_rd128<(D0 + 1) * 32>(qa); f[4] = lds_rd128<(D0 + 1) * 32>(ka); f[5] = lds_rd128<32 * QK_STRIDE + (D0 + 1) * 32>(ka);
    f[6] = lds_rd128<(D0 + 2) * 32>(qa); f[7] = lds_rd128<(D0 + 2) * 32>(ka); f[8] = lds_rd128<32 * QK_STRIDE + (D0 + 2) * 32>(ka);
    f[9] = lds_rd128<(D0 + 3) * 32>(qa); f[10] = lds_rd128<(D0 + 3) * 32>(ka); f[11] = lds_rd128<32 * QK_STRIDE + (D0 + 3) * 32>(ka);
}
__device__ __forceinline__ void sc_mma(f32x16& p0, f32x16& p1, const bf16x8 (&f)[12]) {
#pragma unroll
    for (int i = 0; i < 4; ++i) { p0 = __builtin_amdgcn_mfma_f32_32x32x16_bf16(f[3 * i + 1], f[3 * i], p0, 0, 0, 0); p1 = __builtin_amdgcn_mfma_f32_32x32x16_bf16(f[3 * i + 2], f[3 * i], p1, 0, 0, 0); }
}
template <int D0> __device__ __forceinline__ void qs_load(bf16x8 (&q)[4], s16x4 (&s)[8], int qa, int sa) {
    q[0] = lds_rd128<(D0 + 0) * 32>(qa); s[0] = lds_tr64<(D0 + 0) * 16 * 128>(sa); s[1] = lds_tr64<(D0 + 0) * 16 * 128 + 512>(sa);
    q[1] = lds_rd128<(D0 + 1) * 32>(qa); s[2] = lds_tr64<(D0 + 1) * 16 * 128>(sa); s[3] = lds_tr64<(D0 + 1) * 16 * 128 + 512>(sa);
    q[2] = lds_rd128<(D0 + 2) * 32>(qa); s[4] = lds_tr64<(D0 + 2) * 16 * 128>(sa); s[5] = lds_tr64<(D0 + 2) * 16 * 128 + 512>(sa);
    q[3] = lds_rd128<(D0 + 3) * 32>(qa); s[6] = lds_tr64<(D0 + 3) * 16 * 128>(sa); s[7] = lds_tr64<(D0 + 3) * 16 * 128 + 512>(sa);
}
__device__ __forceinline__ void qs_mma(f32x16& o2, const bf16x8 (&q)[4], const s16x4 (&s)[8]) {
#pragma unroll
    for (int i = 0; i < 4; ++i) o2 = __builtin_amdgcn_mfma_f32_32x32x16_bf16(q[i], TRPK(s[2 * i], s[2 * i + 1]), o2, 0, 0, 0);
}
template <int KS> __device__ __forceinline__ void st_load(s16x4 (&f)[8], int va0, int va1, int ka) {
    f[0] = lds_tr64<KS * 16 * 128>(va0); f[1] = lds_tr64<KS * 16 * 128 + 512>(va0); f[2] = lds_tr64<KS * 16 * 128>(va1); f[3] = lds_tr64<KS * 16 * 128 + 512>(va1);
    f[4] = lds_tr64<KS * 16 * QK_STRIDE>(ka); f[5] = lds_tr64<(KS * 16 + 4) * QK_STRIDE>(ka); f[6] = lds_tr64<KS * 16 * QK_STRIDE + 64>(ka); f[7] = lds_tr64<(KS * 16 + 4) * QK_STRIDE + 64>(ka);
}
__device__ __forceinline__ void st_mma(f32x16 (&acc)[2][2], const s16x4 (&f)[8]) {
    const bf16x8 a0 = TRPK(f[0], f[1]), a1 = TRPK(f[2], f[3]), b0 = TRPK(f[4], f[5]), b1 = TRPK(f[6], f[7]);
    acc[0][0] = __builtin_amdgcn_mfma_f32_32x32x16_bf16(a0, b0, acc[0][0], 0, 0, 0); acc[0][1] = __builtin_amdgcn_mfma_f32_32x32x16_bf16(a0, b1, acc[0][1], 0, 0, 0);
    acc[1][0] = __builtin_amdgcn_mfma_f32_32x32x16_bf16(a1, b0, acc[1][0], 0, 0, 0); acc[1][1] = __builtin_amdgcn_mfma_f32_32x32x16_bf16(a1, b1, acc[1][1], 0, 0, 0);
}

struct Seq {
    const bf16* proj;
    bf16* oret;
    const float* S0;
    float* Sout;
    int nchunks, pad;
    const float* cvt_src;
    bf16* cvt_dst; int cvt_chunk0;
};

__device__ __forceinline__ void unit(const Seq& sq, int h, int s, float l2g, LAS unsigned char* lds) {
    int tid = threadIdx.x; asm volatile("" : "+v"(tid));
    const int wid = __builtin_amdgcn_readfirstlane(tid >> 6), lane = tid & 63, r32 = lane & 31, hi = lane >> 5;
    LAS unsigned char* Qi = lds + Q_OFF; LAS unsigned char* Ki = lds + K_OFF; LAS unsigned char* Vi = lds + V_OFF; LAS unsigned char* Vdi = lds + VD_OFF;
    const bf16* qg = sq.proj + h * 256; const bf16* kg = sq.proj + 2048 + h * 256; const bf16* vg = sq.proj + 4096 + h * 512 + s * 64;
    const int srow = tid >> 3, sch = tid & 7;
    const float vdec = __builtin_amdgcn_exp2f(l2g * 63.0f);
    v4u sq_[4], sk_[4], sv_;
#define RET_SLOAD(c) do { const int t_ = (c) * 64 + srow - sq.pad; if (t_ >= 0) { const size_t ro_ = (size_t)t_ * 12288; \
        _Pragma("unroll") for (int i_ = 0; i_ < 4; ++i_) { sq_[i_] = *(const v4u*)(qg + ro_ + (sch + 8 * i_) * 8); sk_[i_] = *(const v4u*)(kg + ro_ + (sch + 8 * i_) * 8); } \
        sv_ = *(const v4u*)(vg + ro_ + sch * 8); } else { _Pragma("unroll") for (int i_ = 0; i_ < 4; ++i_) { sq_[i_] = (v4u){0u, 0u, 0u, 0u}; sk_[i_] = (v4u){0u, 0u, 0u, 0u}; } sv_ = (v4u){0u, 0u, 0u, 0u}; } } while (0)
#define RET_SWRITE() do { _Pragma("unroll") for (int i_ = 0; i_ < 4; ++i_) { *(LAS v4u*)(Qi + srow * QK_STRIDE + (sch + 8 * i_) * 16) = sq_[i_]; *(LAS v4u*)(Ki + srow * QK_STRIDE + (sch + 8 * i_) * 16) = sk_[i_]; } \
        *(LAS v4u*)(Vi + v_off(srow, sch)) = sv_; v4u d_; d_.x = pk2(bflo(sv_.x) * vdec, bfhi(sv_.x) * vdec); d_.y = pk2(bflo(sv_.y) * vdec, bfhi(sv_.y) * vdec); \
        d_.z = pk2(bflo(sv_.z) * vdec, bfhi(sv_.z) * vdec); d_.w = pk2(bflo(sv_.w) * vdec, bfhi(sv_.w) * vdec); *(LAS v4u*)(Vdi + v_off(srow, sch)) = d_; } while (0)

    const bool statew = wid >= 4; const int x = wid & 3;
    const int ti = x & 1, tn = x >> 1;
    const int rbs = rbase(lane), kbs = kbase(lane) + (statew ? 128 * x : 0), vb0 = vbase(lane, 0), vb1 = vbase(lane, 1), vbt = tn ? vb1 : vb0;
    const int qaddr = (int)(unsigned)(uintptr_t)Qi + rbs + ti * 32 * QK_STRIDE, kaddr = (int)(unsigned)(uintptr_t)Ki + rbs, vaddr = (int)(unsigned)(uintptr_t)Vi + vbt;
    const int vdaddr0 = (int)(unsigned)(uintptr_t)Vdi + vb0, vdaddr1 = (int)(unsigned)(uintptr_t)Vdi + vb1, ktaddr = (int)(unsigned)(uintptr_t)Ki + kbs;
    const int fq2 = (r32 >> 1) & 1, sb0 = (64 * x + r32) * 128 + ((4 * (0 ^ fq2)) << 4) + hi * 8, sb1 = (64 * x + r32) * 128 + ((4 * (1 ^ fq2)) << 4) + hi * 8;
    f32x16 acc[2][2];
#pragma unroll
    for (int rb = 0; rb < 2; ++rb)
#pragma unroll
        for (int cb = 0; cb < 2; ++cb) acc[rb][cb] = (f32x16){};
    __syncthreads();
    if (statew) {
        if (sq.S0) {
            const float pre = __builtin_amdgcn_exp2f(-l2g * (float)sq.pad);
#pragma unroll
            for (int rb = 0; rb < 2; ++rb)
#pragma unroll
                for (int cb = 0; cb < 2; ++cb) { const float* sp = sq.S0 + (size_t)(64 * x + 32 * cb + r32) * 512 + s * 64 + 32 * rb + 4 * hi;
#pragma unroll
                    for (int g = 0; g < 4; ++g) { const f32x4 v = *(const f32x4*)(sp + 8 * g); acc[rb][cb][4 * g + 0] = v.x * pre; acc[rb][cb][4 * g + 1] = v.y * pre; acc[rb][cb][4 * g + 2] = v.z * pre; acc[rb][cb][4 * g + 3] = v.w * pre; } }
        }
#pragma unroll
        for (int rb = 0; rb < 2; ++rb)
#pragma unroll
            for (int cb = 0; cb < 2; ++cb) {
#pragma unroll
                for (int g = 0; g < 4; ++g) { v2u w; w.x = pk2(acc[rb][cb][4 * g], acc[rb][cb][4 * g + 1]); w.y = pk2(acc[rb][cb][4 * g + 2], acc[rb][cb][4 * g + 3]);
                    *(LAS v2u*)(lds + S_OFF + (rb ? sb1 : sb0) + cb * 4096 + g * 16) = w; } }
    }
    RET_SLOAD(0); RET_SWRITE();
    __syncthreads();
    const float cdec = __builtin_amdgcn_exp2f(l2g * 64.0f), gam = __builtin_amdgcn_exp2f(l2g);
    for (int c = 0; c < sq.nchunks; ++c) {
        const LAS unsigned char* Scur = lds + S_OFF + (c & 1) * 32768; LAS unsigned char* Snxt = lds + S_OFF + ((c + 1) & 1) * 32768;
        const bool more = (c + 1 < sq.nchunks);
        if (more) RET_SLOAD(c + 1);
        if (!statew) {
            f32x16 p0 = (f32x16){}, p1 = (f32x16){};
            { bf16x8 fa[12], fb[12];
              sc_load<0>(fa, qaddr, kaddr); LDS_WAIT_SB(0);
              sc_load<4>(fb, qaddr, kaddr); sc_mma(p0, p1, fa); LDS_WAIT_SB(0);
              sc_load<8>(fa, qaddr, kaddr); sc_mma(p0, p1, fb); LDS_WAIT_SB(0);
              sc_load<12>(fb, qaddr, kaddr); sc_mma(p0, p1, fa); LDS_WAIT_SB(0);
              sc_mma(p0, p1, fb); }
            const int ipos = 32 * ti + r32;
#pragma unroll
            for (int r = 0; r < 16; ++r) { const int j0 = crow(r, hi), j1 = 32 + j0;
                p0[r] = (ipos >= j0) ? p0[r] : 0.f;
                p1[r] = (ipos >= j1) ? p1[r] : 0.f; }
            bf16x8 pa0, pa1, pa2, pa3;
#define RET_PK4(P, BASE, OUT) do { unsigned a0 = pk2(P[BASE + 0], P[BASE + 1]), a1 = pk2(P[BASE + 2], P[BASE + 3]); \
    unsigned b0 = pk2(P[BASE + 4], P[BASE + 5]), b1 = pk2(P[BASE + 6], P[BASE + 7]); \
    auto r0 = __builtin_amdgcn_permlane32_swap(a0, b0, false, false); auto r1 = __builtin_amdgcn_permlane32_swap(a1, b1, false, false); \
    v4u w = {r0[0], r1[0], r0[1], r1[1]}; OUT = __builtin_bit_cast(bf16x8, w); } while (0)
            RET_PK4(p0, 0, pa0); RET_PK4(p0, 8, pa1); RET_PK4(p1, 0, pa2); RET_PK4(p1, 8, pa3);
#undef RET_PK4
            f32x16 o2 = (f32x16){};
            const int saddr = (int)(unsigned)(uintptr_t)Scur + vbt;
            { bf16x8 qa_[4], qb_[4]; s16x4 sa_[8], sb_[8];
              qs_load<0>(qa_, sa_, qaddr, saddr); LDS_WAIT_SB(0);
              qs_load<4>(qb_, sb_, qaddr, saddr); qs_mma(o2, qa_, sa_); LDS_WAIT_SB(0);
              qs_load<8>(qa_, sa_, qaddr, saddr); qs_mma(o2, qb_, sb_); LDS_WAIT_SB(0);
              qs_load<12>(qb_, sb_, qaddr, saddr); qs_mma(o2, qa_, sa_); LDS_WAIT_SB(0);
              s16x4 v_[8];
              v_[0] = lds_tr64<0>(vaddr); v_[1] = lds_tr64<512>(vaddr); v_[2] = lds_tr64<16 * 128>(vaddr); v_[3] = lds_tr64<16 * 128 + 512>(vaddr);
              v_[4] = lds_tr64<32 * 128>(vaddr); v_[5] = lds_tr64<32 * 128 + 512>(vaddr); v_[6] = lds_tr64<48 * 128>(vaddr); v_[7] = lds_tr64<48 * 128 + 512>(vaddr);
              qs_mma(o2, qb_, sb_); LDS_WAIT_SB(0);
              f32x16 o1_;
#pragma unroll
              for (int r = 0; r < 16; ++r) o1_[r] = o2[r] * gam;
              o1_ = __builtin_amdgcn_mfma_f32_32x32x16_bf16(pa0, TRPK(v_[0], v_[1]), o1_, 0, 0, 0);
              o1_ = __builtin_amdgcn_mfma_f32_32x32x16_bf16(pa1, TRPK(v_[2], v_[3]), o1_, 0, 0, 0);
              o1_ = __builtin_amdgcn_mfma_f32_32x32x16_bf16(pa2, TRPK(v_[4], v_[5]), o1_, 0, 0, 0);
              o1_ = __builtin_amdgcn_mfma_f32_32x32x16_bf16(pa3, TRPK(v_[6], v_[7]), o1_, 0, 0, 0);
              o2 = o1_; }
            const f32x16 o1 = o2;
            bf16* ob = sq.oret + h * 512 + s * 64 + 32 * tn + r32;
            if (c * 64 + 32 * ti >= sq.pad) {
                bf16* ob2 = ob + (size_t)(c * 64 + 32 * ti - sq.pad) * 4096;
#pragma unroll
                for (int r = 0; r < 16; ++r) ob2[(size_t)crow(r, hi) * 4096] = (bf16)(pk2(o1[r], 0.f) & 0xffffu); }
        } else {
            f32x4 cv_[4]; int cchunk_ = 0;
            if (sq.cvt_src) { cchunk_ = sq.cvt_chunk0 + c * 4 + x; const f32x4* sp_ = (const f32x4*)(sq.cvt_src + (size_t)cchunk_ * 1024) + lane * 4;
#pragma unroll
                for (int i_ = 0; i_ < 4; ++i_) cv_[i_] = sp_[i_]; }
#pragma unroll
            for (int rb = 0; rb < 2; ++rb)
#pragma unroll
                for (int cb = 0; cb < 2; ++cb) acc[rb][cb] = acc[rb][cb] * cdec;
            { s16x4 fa[8], fb[8];
              st_load<0>(fa, vdaddr0, vdaddr1, ktaddr); LDS_WAIT_SB(0);
              st_load<1>(fb, vdaddr0, vdaddr1, ktaddr); st_mma(acc, fa); LDS_WAIT_SB(0);
              st_load<2>(fa, vdaddr0, vdaddr1, ktaddr); st_mma(acc, fb); LDS_WAIT_SB(0);
              st_load<3>(fb, vdaddr0, vdaddr1, ktaddr); st_mma(acc, fa); LDS_WAIT_SB(0);
              st_mma(acc, fb); }
            if (more) {
#pragma unroll
                for (int rb = 0; rb < 2; ++rb)
#pragma unroll
                    for (int cb = 0; cb < 2; ++cb) {
#pragma unroll
                        for (int g = 0; g < 4; ++g) { v2u w; w.x = pk2(acc[rb][cb][4 * g], acc[rb][cb][4 * g + 1]); w.y = pk2(acc[rb][cb][4 * g + 2], acc[rb][cb][4 * g + 3]);
                            *(LAS v2u*)(Snxt + (rb ? sb1 : sb0) + cb * 4096 + g * 16) = w; } }
            }
            if (sq.cvt_src) { const int e0_ = cchunk_ * 1024 + lane * 16, row_ = e0_ >> 11, col_ = e0_ & 2047;
                bf16* dp_ = sq.cvt_dst + ((size_t)(row_ >> 10) * SKV_S + (row_ & 1023)) * 2048 + col_;
                v4u w0_, w1_; w0_.x = pk2(cv_[0].x, cv_[0].y); w0_.y = pk2(cv_[0].z, cv_[0].w); w0_.z = pk2(cv_[1].x, cv_[1].y); w0_.w = pk2(cv_[1].z, cv_[1].w);
                w1_.x = pk2(cv_[2].x, cv_[2].y); w1_.y = pk2(cv_[2].z, cv_[2].w); w1_.z = pk2(cv_[3].x, cv_[3].y); w1_.w = pk2(cv_[3].z, cv_[3].w);
                *(v4u*)dp_ = w0_; *(v4u*)(dp_ + 8) = w1_; }
        }
        __syncthreads();
        if (more) { RET_SWRITE(); }
        __syncthreads();
    }
    if (statew) {
#pragma unroll
        for (int rb = 0; rb < 2; ++rb)
#pragma unroll
            for (int cb = 0; cb < 2; ++cb) { float* sp = sq.Sout + (size_t)(64 * x + 32 * cb + r32) * 512 + s * 64 + 32 * rb + 4 * hi;
#pragma unroll
                for (int g = 0; g < 4; ++g) *(f32x4*)(sp + 8 * g) = (f32x4){acc[rb][cb][4 * g], acc[rb][cb][4 * g + 1], acc[rb][cb][4 * g + 2], acc[rb][cb][4 * g + 3]}; }
    }
#undef RET_SLOAD
#undef RET_SWRITE
}
}

namespace a16 {
constexpr int KST = 288, VST = 544;
constexpr int SHM_K = 64 * KST, SHM_V = 64 * VST, SHM_T = SHM_K + SHM_V, SHM_SCR = 3 * SHM_T, SHM_ATT = SHM_SCR + 8 * 256;
static_assert(SHM_ATT <= LDS_MAIN, "att16 LDS map");
constexpr float SCALE = 0.088388347648318440f, THR = 8.f;
constexpr int LDQ = 2048, LDK = 2048, LDO = 4096;
typedef float f32x2 __attribute__((ext_vector_type(2)));
struct Sc { f32x4 k[4]; };
__device__ __forceinline__ s16x4 vtr(const LAS unsigned char* p) { return __builtin_bit_cast(s16x4, __builtin_amdgcn_ds_read_tr16_b64_v4i16((LAS ret::v4i16_t*)p)); }

template <int OFF> __device__ __forceinline__ bf16x8 rd128(int a) { return lds_rd128<OFF>(a); }
template <int OFF> __device__ __forceinline__ s16x4 tr64(int a) { return lds_tr64<OFF>(a); }
#define A16_WAIT(n) do { asm volatile("s_waitcnt lgkmcnt(" #n ")" ::: "memory"); __builtin_amdgcn_sched_barrier(0); } while (0)
template <int KB, int S2, int KSTR = KST> __device__ __forceinline__ void kload(bf16x8 (&f)[2], int ka) { f[0] = rd128<KB * 16 * KSTR + S2 * 64>(ka); f[1] = rd128<KB * 16 * KSTR + S2 * 64 + 64>(ka); }
template <bool LEAN, int KSTR = KST> __device__ __forceinline__ void qkt(Sc& sc, int ka, const bf16x8 (&qf)[4]) {
    if constexpr (LEAN) {
        bf16x8 fa[2], fb[2];
#pragma unroll
        for (int kb = 0; kb < 4; ++kb) sc.k[kb] = (f32x4){0.f, 0.f, 0.f, 0.f};
#define A16_KMMA(KB, S2, F) do { sc.k[KB] = __builtin_amdgcn_mfma_f32_16x16x32_bf16(F[0], qf[S2], sc.k[KB], 0, 0, 0); sc.k[KB] = __builtin_amdgcn_mfma_f32_16x16x32_bf16(F[1], qf[S2 + 1], sc.k[KB], 0, 0, 0); } while (0)
        kload<0, 0, KSTR>(fa, ka); kload<0, 2, KSTR>(fb, ka);
        A16_WAIT(2); A16_KMMA(0, 0, fa); kload<1, 0, KSTR>(fa, ka);
        A16_WAIT(2); A16_KMMA(0, 2, fb); kload<1, 2, KSTR>(fb, ka);
        A16_WAIT(2); A16_KMMA(1, 0, fa); kload<2, 0, KSTR>(fa, ka);
        A16_WAIT(2); A16_KMMA(1, 2, fb); kload<2, 2, KSTR>(fb, ka);
        A16_WAIT(2); A16_KMMA(2, 0, fa); kload<3, 0, KSTR>(fa, ka);
        A16_WAIT(2); A16_KMMA(2, 2, fb); kload<3, 2, KSTR>(fb, ka);
        A16_WAIT(2); A16_KMMA(3, 0, fa);
        A16_WAIT(0); A16_KMMA(3, 2, fb);
#undef A16_KMMA
        return;
    }
    bf16x8 fa[4], fb[4];
#define A16_KL4(KB, F) do { F[0] = rd128<KB * 16 * KSTR>(ka); F[1] = rd128<KB * 16 * KSTR + 64>(ka); F[2] = rd128<KB * 16 * KSTR + 128>(ka); F[3] = rd128<KB * 16 * KSTR + 192>(ka); } while (0)
#define A16_KM4(KB, F) do { f32x4 a_ = (f32x4){0.f, 0.f, 0.f, 0.f}; _Pragma("unroll") for (int s = 0; s < 4; ++s) a_ = __builtin_amdgcn_mfma_f32_16x16x32_bf16(F[s], qf[s], a_, 0, 0, 0); sc.k[KB] = a_; } while (0)
    A16_KL4(0, fa); A16_KL4(1, fb);
    A16_WAIT(4); A16_KM4(0, fa); A16_KL4(2, fa);
    A16_WAIT(4); A16_KM4(1, fb); A16_KL4(3, fb);
    A16_WAIT(4); A16_KM4(2, fa);
    A16_WAIT(0); A16_KM4(3, fb);
#undef A16_KL4
#undef A16_KM4
}
template <bool FAST>
__device__ __forceinline__ bool softmax_tile(Sc& sc, float& m_reg, float& l_reg, float& alpha, float qrel, float nb, int kl, int g, bool past) {
    constexpr float C = SCALE * 1.4426950408889634f;
    if (FAST && past) {
        const f32x2 n2 = {nb, nb};
#pragma unroll
        for (int kb = 0; kb < 4; ++kb) { const float b = qrel - 16.f * kb; f32x2 e01 = {b, b - 1.f}, e23 = e01 - 2.f;
            f32x2 a = {sc.k[kb][0], sc.k[kb][1]}, c = {sc.k[kb][2], sc.k[kb][3]}; a = __builtin_elementwise_fma(e01, n2, a); c = __builtin_elementwise_fma(e23, n2, c);
            sc.k[kb] = (f32x4){a.x, a.y, c.x, c.y}; }
    } else {
#pragma unroll
        for (int kb = 0; kb < 4; ++kb) { const float b = qrel - 16.f * kb, e1 = b - 1.f, e2 = b - 2.f, e3 = e1 - 2.f;
            sc.k[kb][0] = fmaf(fabsf(b), nb, sc.k[kb][0]); sc.k[kb][1] = fmaf(fabsf(e1), nb, sc.k[kb][1]); sc.k[kb][2] = fmaf(fabsf(e2), nb, sc.k[kb][2]); sc.k[kb][3] = fmaf(fabsf(e3), nb, sc.k[kb][3]); }
        if (kl < 64) {
#pragma unroll
            for (int kb = 0; kb < 4; ++kb)
#pragma unroll
                for (int r = 0; r < 4; ++r) if (16 * kb + 4 * g + r >= kl) sc.k[kb][r] = -3.0e38f;
        }
    }
    float pmax = fmaxf(fmaxf(sc.k[0][0], sc.k[0][1]), fmaxf(sc.k[0][2], sc.k[0][3]));
#pragma unroll
    for (int kb = 1; kb < 4; ++kb) pmax = fmaxf(pmax, fmaxf(fmaxf(sc.k[kb][0], sc.k[kb][1]), fmaxf(sc.k[kb][2], sc.k[kb][3])));
    { auto rr = __builtin_amdgcn_permlane16_swap(__float_as_uint(pmax), __float_as_uint(pmax), false, false); pmax = fmaxf(__uint_as_float(rr[0]), __uint_as_float(rr[1])); }
    { auto rr = __builtin_amdgcn_permlane32_swap(__float_as_uint(pmax), __float_as_uint(pmax), false, false); pmax = fmaxf(__uint_as_float(rr[0]), __uint_as_float(rr[1])); }
    if (__all(pmax - m_reg < -160.f / C)) { alpha = 1.f; return true; }
    float mn;
    if (__builtin_expect(__all(pmax - m_reg <= THR / SCALE), 1)) { mn = m_reg; alpha = 1.f; }
    else { mn = fmaxf(m_reg, pmax); alpha = __builtin_amdgcn_exp2f((m_reg - mn) * C); m_reg = mn; }
    const float mnC = -mn * C; float ps = 0.f;
#pragma unroll
    for (int kb = 0; kb < 4; ++kb)
#pragma unroll
        for (int r = 0; r < 4; ++r) { const float p = __builtin_amdgcn_exp2f(fmaf(sc.k[kb][r], C, mnC)); sc.k[kb][r] = p; ps += p; }
    { auto rr = __builtin_amdgcn_permlane16_swap(__float_as_uint(ps), __float_as_uint(ps), false, false); ps = __uint_as_float(rr[0]) + __uint_as_float(rr[1]); }
    { auto rr = __builtin_amdgcn_permlane32_swap(__float_as_uint(ps), __float_as_uint(ps), false, false); ps = __uint_as_float(rr[0]) + __uint_as_float(rr[1]); }
    l_reg = l_reg * alpha + ps;
    return false;
}
template <int CB> __device__ __forceinline__ void vload(s16x4 (&f)[4], int va) {
    f[0] = tr64<CB * 32>(va); f[1] = tr64<16 * VST + CB * 32>(va); f[2] = tr64<32 * VST + CB * 32>(va); f[3] = tr64<48 * VST + CB * 32>(va);
}
template <int CB> __device__ __forceinline__ void vmma(f32x4 (&o)[16], const s16x4 (&f)[4], const bf16x8 (&pa)[2]) {
#pragma unroll
    for (int s = 0; s < 2; ++s) { const s16x4 lo = f[2 * s], hi = f[2 * s + 1];
        o[CB] = __builtin_amdgcn_mfma_f32_16x16x32_bf16(pa[s], (bf16x8){lo[0], lo[1], lo[2], lo[3], hi[0], hi[1], hi[2], hi[3]}, o[CB], 0, 0, 0); }
}
template <bool LEAN> __device__ __forceinline__ void pv(f32x4 (&o)[16], const Sc& sc, int va) {
    bf16x8 pa[2];
#pragma unroll
    for (int s = 0; s < 2; ++s) { v4u w; w.x = pk2(sc.k[2 * s][0], sc.k[2 * s][1]); w.y = pk2(sc.k[2 * s][2], sc.k[2 * s][3]); w.z = pk2(sc.k[2 * s + 1][0], sc.k[2 * s + 1][1]); w.w = pk2(sc.k[2 * s + 1][2], sc.k[2 * s + 1][3]);
        pa[s] = __builtin_bit_cast(bf16x8, w); }
    if constexpr (LEAN) {
        s16x4 fa[4], fb[4];
        vload<0>(fa, va); vload<1>(fb, va);
#define A16_PVL(CB, F, NEXT) do { A16_WAIT(4); vmma<CB>(o, F, pa); vload<NEXT>(F, va); } while (0)
        A16_PVL(0, fa, 2); A16_PVL(1, fb, 3); A16_PVL(2, fa, 4); A16_PVL(3, fb, 5); A16_PVL(4, fa, 6); A16_PVL(5, fb, 7); A16_PVL(6, fa, 8); A16_PVL(7, fb, 9);
        A16_PVL(8, fa, 10); A16_PVL(9, fb, 11); A16_PVL(10, fa, 12); A16_PVL(11, fb, 13); A16_PVL(12, fa, 14); A16_PVL(13, fb, 15);
        A16_WAIT(4); vmma<14>(o, fa, pa);
        A16_WAIT(0); vmma<15>(o, fb, pa);
#undef A16_PVL
        return;
    }
    s16x4 fa[4], fb[4], fc[4], fd[4];
    vload<0>(fa, va); vload<1>(fb, va); vload<2>(fc, va); vload<3>(fd, va);
#define A16_PV2(CB, F, G, NEXT) do { A16_WAIT(8); vmma<CB>(o, F, pa); vmma<CB + 1>(o, G, pa); vload<NEXT>(F, va); vload<NEXT + 1>(G, va); } while (0)
    A16_PV2(0, fa, fb, 4); A16_PV2(2, fc, fd, 6); A16_PV2(4, fa, fb, 8); A16_PV2(6, fc, fd, 10); A16_PV2(8, fa, fb, 12); A16_PV2(10, fc, fd, 14);
    A16_WAIT(8); vmma<12>(o, fa, pa); vmma<13>(o, fb, pa);
    A16_WAIT(0); vmma<14>(o, fc, pa); vmma<15>(o, fd, pa);
#undef A16_PV2
}
template <bool GUARD>
__device__ __forceinline__ void attn_core(f32x4 (&o)[16], const bf16* __restrict__ Qb, const bf16* __restrict__ Kh, const bf16* __restrict__ Vh,
                                          int NT, int qpos0, int klim, bool act, float nb, LAS unsigned char* lds, const unsigned* __restrict__ kmax4) {
    int tid = threadIdx.x; asm volatile("" : "+v"(tid));
    const int wid = __builtin_amdgcn_readfirstlane(tid >> 6), lane = tid & 63, q16 = lane & 15, g = lane >> 4;
    LAS float* scr = (LAS float*)(lds + SHM_SCR + wid * 256);
    const int kb_ = q16 * KST + g * 16;
    const int vb_ = (4 * g + (q16 >> 2)) * VST + (q16 & 3) * 8;
    const int srow = tid >> 3, sch = tid & 7;
    const unsigned soff = (unsigned)(srow * LDK * 2 + sch * 16);
    const int kwr = srow * KST + sch * 16, vwr = srow * VST + sch * 16;
    const int kaddr0 = (int)(unsigned)(uintptr_t)lds + kb_, vaddr0 = (int)(unsigned)(uintptr_t)lds + SHM_K + vb_;
    float m_reg = -1e30f, l_reg = 0.f;
#pragma unroll
    for (int cb = 0; cb < 16; ++cb) o[cb] = (f32x4){0.f, 0.f, 0.f, 0.f};
    bf16x8 qf[4];
#define CMP(...) do { if (!GUARD || act) { __VA_ARGS__ } } while (0)
#pragma unroll
    for (int s = 0; s < 4; ++s) qf[s] = (bf16x8){0, 0, 0, 0, 0, 0, 0, 0};
    CMP( const bf16* Qw = Qb + (size_t)(wid * 16 + q16) * LDQ + g * 8;
         _Pragma("unroll") for (int s = 0; s < 4; ++s) qf[s] = *(const bf16x8*)(Qw + s * 32); );
    const float qposf = (float)(qpos0 + wid * 16 + q16 - 4 * g); const int qmin = qpos0 + wid * 16;
    float qn2 = 0.f;
    if constexpr (!GUARD) {
#pragma unroll
        for (int s = 0; s < 4; ++s) { const v4u w = __builtin_bit_cast(v4u, qf[s]);
            qn2 += (bflo(w.x) * bflo(w.x) + bfhi(w.x) * bfhi(w.x)) + (bflo(w.y) * bflo(w.y) + bfhi(w.y) * bfhi(w.y)) + (bflo(w.z) * bflo(w.z) + bfhi(w.z) * bfhi(w.z)) + (bflo(w.w) * bflo(w.w) + bfhi(w.w) * bfhi(w.w)); }
        { auto rr = __builtin_amdgcn_permlane16_swap(__float_as_uint(qn2), __float_as_uint(qn2), false, false); qn2 = __uint_as_float(rr[0]) + __uint_as_float(rr[1]); }
        { auto rr = __builtin_amdgcn_permlane32_swap(__float_as_uint(qn2), __float_as_uint(qn2), false, false); qn2 = __uint_as_float(rr[0]) + __uint_as_float(rr[1]); }
        qn2 = fmaxf(qn2, __int_as_float(__builtin_amdgcn_update_dpp(0, __float_as_int(qn2), 0xB1, 0xF, 0xF, true)));
        qn2 = fmaxf(qn2, __int_as_float(__builtin_amdgcn_update_dpp(0, __float_as_int(qn2), 0x4E, 0xF, 0xF, true)));
        qn2 = fmaxf(qn2, __int_as_float(__builtin_amdgcn_update_dpp(0, __float_as_int(qn2), 0x141, 0xF, 0xF, true)));
        qn2 = fmaxf(qn2, __int_as_float(__builtin_amdgcn_update_dpp(0, __float_as_int(qn2), 0x140, 0xF, 0xF, true)));
    }
    v4u sk_[2], sv_[4];
#define TL(i) (NT - 1 - (i))
#define SLOAD(idx) do { const char* kt_ = (const char*)Kh + (size_t)(TL(idx) * 64) * (LDK * 2) + soff; const char* vt_ = (const char*)Vh + (size_t)(TL(idx) * 64) * (LDK * 2) + soff; \
        _Pragma("unroll") for (int i_ = 0; i_ < 2; ++i_) sk_[i_] = *(const v4u*)(kt_ + i_ * 128); _Pragma("unroll") for (int i_ = 0; i_ < 4; ++i_) sv_[i_] = *(const v4u*)(vt_ + i_ * 128); } while (0)
#define SWRITE(b) do { LAS unsigned char* kt_ = lds + (b) * SHM_T; LAS unsigned char* vt_ = kt_ + SHM_K; \
        _Pragma("unroll") for (int i_ = 0; i_ < 2; ++i_) *(LAS v4u*)(kt_ + kwr + i_ * 128) = sk_[i_]; _Pragma("unroll") for (int i_ = 0; i_ < 4; ++i_) *(LAS v4u*)(vt_ + vwr + i_ * 128) = sv_[i_]; } while (0)
#define KT(b) (kaddr0 + (b) * SHM_T)
#define VT(b) (vaddr0 + (b) * SHM_T)
#define RESC(a) do { if (__any((a) < 1.f)) { if (g == 0) scr[q16] = (a); asm volatile("s_waitcnt lgkmcnt(0)" ::: "memory"); const f32x4 al_ = *(const LAS f32x4*)(scr + 4 * g); \
        _Pragma("unroll") for (int cb = 0; cb < 16; ++cb) o[cb] = o[cb] * al_; } } while (0)
#define PSM(S, AL, IDX) softmax_tile<!GUARD>(S, m_reg, l_reg, AL, qposf - (float)(TL(IDX) * 64), nb, klim - TL(IDX) * 64, g, TL(IDX) * 64 + 63 < qmin)
    Sc pA, pB; float alA = 1.f, alB = 1.f; bool dA = false, dB = false;
    constexpr bool STAG = !GUARD;
#define MIDBAR() do { if (STAG) asm volatile("s_waitcnt lgkmcnt(0)\n\ts_barrier" ::: "memory"); } while (0)
    __syncthreads();
    SLOAD(0); SWRITE(0); SLOAD(1);
    if constexpr (!GUARD) { if (lane == 0) scr[32] = qn2; }
    __syncthreads();
    int NL = NT;
    if constexpr (!GUARD) {
        float q2 = 0.f;
#pragma unroll
        for (int w = 0; w < 8; ++w) q2 = fmaxf(q2, ((const LAS float*)(lds + SHM_SCR + w * 256))[32]);
        float k2 = 0.f;
#pragma unroll
        for (int i = 0; i < 4; ++i) k2 += __uint_as_float(__hip_atomic_load(kmax4 + i, __ATOMIC_RELAXED, __HIP_MEMORY_SCOPE_AGENT));
        const float qk = sqrtf(q2 * k2) * 1.02f;
        const float dcut = (2.f * qk + THR / SCALE + 160.f / (SCALE * 1.4426950408889634f)) / -nb;
        const float nsk = floorf(((float)qpos0 - dcut) * (1.0f / 64.0f)) - 1.f;
        int nskip = nsk > 0.f ? ((int)nsk & ~1) : 0;
        nskip = __builtin_amdgcn_readfirstlane(nskip);
        NL = NT - nskip; if (NL < 2) NL = 2;
    }
    if (STAG && wid >= 4) asm volatile("s_barrier" ::: "memory");
    SWRITE(1); if (2 < NL) SLOAD(2);
    CMP( qkt<GUARD>(pA, KT(0), qf); MIDBAR(); dA = PSM(pA, alA, 0); RESC(alA); );
    int bp = 0, bc = 1, bn = 2;
    for (int j = 1; j + 1 < NL; j += 2) {
        __syncthreads();
        SWRITE(bn); SLOAD(j + 2);
        CMP( qkt<GUARD>(pB, KT(bc), qf); if (!dA) pv<GUARD>(o, pA, VT(bp)); MIDBAR(); dB = PSM(pB, alB, j); RESC(alB); );
        { const int t_ = bp; bp = bc; bc = bn; bn = t_; }
        __syncthreads();
        SWRITE(bn); if (j + 3 < NL) SLOAD(j + 3);
        CMP( qkt<GUARD>(pA, KT(bc), qf); if (!dB) pv<GUARD>(o, pB, VT(bp)); MIDBAR(); dA = PSM(pA, alA, j + 1); RESC(alA); );
        { const int t_ = bp; bp = bc; bc = bn; bn = t_; }
    }
    __syncthreads();
    CMP( qkt<GUARD>(pB, KT(bc), qf); if (!dA) pv<GUARD>(o, pA, VT(bp)); MIDBAR(); dB = PSM(pB, alB, NL - 1); RESC(alB);
         if (STAG && wid < 4) asm volatile("s_barrier" ::: "memory");
         if (!dB) pv<GUARD>(o, pB, VT(bc));
         if (g == 0) scr[q16] = l_reg; asm volatile("s_waitcnt lgkmcnt(0)" ::: "memory");
         const f32x4 lv = *(const LAS f32x4*)(scr + 4 * g);
         const f32x4 rl = (f32x4){__builtin_amdgcn_rcpf(lv.x), __builtin_amdgcn_rcpf(lv.y), __builtin_amdgcn_rcpf(lv.z), __builtin_amdgcn_rcpf(lv.w)};
         _Pragma("unroll") for (int cb = 0; cb < 16; ++cb) o[cb] = o[cb] * rl; );
#undef CMP
#undef TL
#undef SLOAD
#undef SWRITE
#undef KT
#undef VT
#undef RESC
#undef PSM
#undef MIDBAR
}
template <bool GUARD>
__device__ __forceinline__ void attn_pair(const bf16* __restrict__ Qb, const bf16* __restrict__ Kh, const bf16* __restrict__ Vh, bf16* __restrict__ OAb,
                                          int NT, int qpos0, int klim, bool act, float nb, float lam, LAS unsigned char* lds, const unsigned* __restrict__ kmax8) {
    f32x4 o[16];
    attn_core<GUARD>(o, Qb, Kh, Vh, NT, qpos0, klim, act, nb, lds, kmax8);
    unsigned p0[32];
#pragma unroll
    for (int cb = 0; cb < 16; ++cb) { p0[2 * cb] = pk2(o[cb].x, o[cb].y); p0[2 * cb + 1] = pk2(o[cb].z, o[cb].w); }
    attn_core<GUARD>(o, Qb + 128, Kh + 128, Vh, NT, qpos0, klim, act, nb, lds, kmax8 + 4);
    if (!GUARD || act) {
        int tid = threadIdx.x; asm volatile("" : "+v"(tid));
        const int wid = __builtin_amdgcn_readfirstlane(tid >> 6), lane = tid & 63, q16 = lane & 15, g = lane >> 4;
        f32x4 ss = (f32x4){0.f, 0.f, 0.f, 0.f};
#pragma unroll
        for (int cb = 0; cb < 16; ++cb) { const f32x4 a0 = (f32x4){bflo(p0[2 * cb]), bfhi(p0[2 * cb]), bflo(p0[2 * cb + 1]), bfhi(p0[2 * cb + 1])}; o[cb] = a0 - o[cb] * lam; ss = ss + o[cb] * o[cb]; }
#pragma unroll
        for (int m = 1; m < 16; m <<= 1) { ss.x += __shfl_xor(ss.x, m); ss.y += __shfl_xor(ss.y, m); ss.z += __shfl_xor(ss.z, m); ss.w += __shfl_xor(ss.w, m); }
        const f32x4 r = (f32x4){1.0f / sqrtf(ss.x * (1.0f / 256.0f) + EPS), 1.0f / sqrtf(ss.y * (1.0f / 256.0f) + EPS), 1.0f / sqrtf(ss.z * (1.0f / 256.0f) + EPS), 1.0f / sqrtf(ss.w * (1.0f / 256.0f) + EPS)};
        bf16* Ow = OAb + (size_t)(wid * 16 + 4 * g) * 2048 + q16;
#pragma unroll
        for (int cb = 0; cb < 16; ++cb) { const f32x4 v = o[cb] * r;
            Ow[cb * 16] = (bf16)(pk2(v.x, 0.f) & 0xffffu); Ow[2048 + cb * 16] = (bf16)(pk2(v.y, 0.f) & 0xffffu); Ow[2 * 2048 + cb * 16] = (bf16)(pk2(v.z, 0.f) & 0xffffu); Ow[3 * 2048 + cb * 16] = (bf16)(pk2(v.w, 0.f) & 0xffffu); }
    }
}

constexpr int KS2 = 544, SH2_K = 64 * KS2, SH2_T = SH2_K + SHM_V, SH2_SCR = 2 * SH2_T;
static_assert(SH2_SCR + 8 * 256 <= LDS_MAIN && 2 * 64 * 1024 <= SH2_SCR, "sample attention LDS map");
__device__ __forceinline__ void attn_sample2(const bf16* __restrict__ Qb, const bf16* __restrict__ Kh, const bf16* __restrict__ Vh, bf16* __restrict__ OAb,
                                             int NT, int qpos0, int klim, float nb, float lam, LAS unsigned char* lds) {
    int tid = threadIdx.x; asm volatile("" : "+v"(tid));
    const int wid = __builtin_amdgcn_readfirstlane(tid >> 6), lane = tid & 63, q16 = lane & 15, g = lane >> 4;
    const bool act = wid < 4; const int mp = (wid >> 1) & 1, r0 = (wid & 1) * 16;
    LAS float* scr = (LAS float*)(lds + SH2_SCR + wid * 256);
    const int srow = tid >> 3, sch = tid & 7;
    const unsigned soff = (unsigned)(srow * LDK * 2 + sch * 16);
    const int kwr = srow * KS2 + sch * 16, vwr = srow * VST + sch * 16;
    const int kaddr0 = (int)(unsigned)(uintptr_t)lds + q16 * KS2 + g * 16 + mp * 256;
    const int vaddr0 = (int)(unsigned)(uintptr_t)lds + SH2_K + (4 * g + (q16 >> 2)) * VST + (q16 & 3) * 8;
    float m_reg = -1e30f, l_reg = 0.f;
    f32x4 o[16];
#pragma unroll
    for (int cb = 0; cb < 16; ++cb) o[cb] = (f32x4){0.f, 0.f, 0.f, 0.f};
    bf16x8 qf[4];
#pragma unroll
    for (int s = 0; s < 4; ++s) qf[s] = (bf16x8){0, 0, 0, 0, 0, 0, 0, 0};
    if (act) { const bf16* Qw = Qb + (size_t)(r0 + q16) * LDQ + mp * 128 + g * 8;
#pragma unroll
        for (int s = 0; s < 4; ++s) qf[s] = *(const bf16x8*)(Qw + s * 32); }
    const float qposf = (float)(qpos0 + r0 + q16 - 4 * g);
    v4u sk_[4], sv_[4];
#define TL(i) (NT - 1 - (i))
#define SLOAD(idx) do { const char* kt_ = (const char*)Kh + (size_t)(TL(idx) * 64) * (LDK * 2) + soff; const char* vt_ = (const char*)Vh + (size_t)(TL(idx) * 64) * (LDK * 2) + soff; \
        _Pragma("unroll") for (int i_ = 0; i_ < 4; ++i_) { sk_[i_] = *(const v4u*)(kt_ + i_ * 128); sv_[i_] = *(const v4u*)(vt_ + i_ * 128); } } while (0)
#define SWRITE(b) do { LAS unsigned char* kt_ = lds + (b) * SH2_T; LAS unsigned char* vt_ = kt_ + SH2_K; \
        _Pragma("unroll") for (int i_ = 0; i_ < 4; ++i_) { *(LAS v4u*)(kt_ + kwr + i_ * 128) = sk_[i_]; *(LAS v4u*)(vt_ + vwr + i_ * 128) = sv_[i_]; } } while (0)
    __syncthreads();
    SLOAD(0); SWRITE(0); if (1 < NT) SLOAD(1);
    __syncthreads();
    for (int j = 0; j < NT; ++j) {
        const int cur = j & 1;
        if (j + 1 < NT) { SWRITE(1 - cur); if (j + 2 < NT) SLOAD(j + 2); }
        if (act) { Sc p; float al = 1.f;
            qkt<false, KS2>(p, kaddr0 + cur * SH2_T, qf);
            const bool dead = softmax_tile<false>(p, m_reg, l_reg, al, qposf - (float)(TL(j) * 64), nb, klim - TL(j) * 64, g, false);
            if (__any(al < 1.f)) { if (g == 0) scr[q16] = al; asm volatile("s_waitcnt lgkmcnt(0)" ::: "memory"); const f32x4 al_ = *(const LAS f32x4*)(scr + 4 * g);
#pragma unroll
                for (int cb = 0; cb < 16; ++cb) o[cb] = o[cb] * al_; }
            if (!dead) pv<false>(o, p, vaddr0 + cur * SH2_T); }
        __syncthreads();
    }
#undef TL
#undef SLOAD
#undef SWRITE
    if (act) { if (g == 0) scr[q16] = l_reg; asm volatile("s_waitcnt lgkmcnt(0)" ::: "memory");
        const f32x4 lv = *(const LAS f32x4*)(scr + 4 * g);
        const f32x4 rl = (f32x4){__builtin_amdgcn_rcpf(lv.x), __builtin_amdgcn_rcpf(lv.y), __builtin_amdgcn_rcpf(lv.z), __builtin_amdgcn_rcpf(lv.w)};
#pragma unroll
        for (int cb = 0; cb < 16; ++cb) o[cb] = o[cb] * rl; }
    LAS f32x4* xch = (LAS f32x4*)(lds + (wid & 1) * 65536) + lane;
    if (act && mp == 1) {
#pragma unroll
        for (int cb = 0; cb < 16; ++cb) xch[cb * 64] = o[cb]; }
    __syncthreads();
    if (act && mp == 0) {
        f32x4 ss = (f32x4){0.f, 0.f, 0.f, 0.f};
#pragma unroll
        for (int cb = 0; cb < 16; ++cb) { const f32x4 o1 = xch[cb * 64]; o[cb] = o[cb] - o1 * lam; ss = ss + o[cb] * o[cb]; }
#pragma unroll
        for (int m = 1; m < 16; m <<= 1) { ss.x += __shfl_xor(ss.x, m); ss.y += __shfl_xor(ss.y, m); ss.z += __shfl_xor(ss.z, m); ss.w += __shfl_xor(ss.w, m); }
        const f32x4 r = (f32x4){1.0f / sqrtf(ss.x * (1.0f / 256.0f) + EPS), 1.0f / sqrtf(ss.y * (1.0f / 256.0f) + EPS), 1.0f / sqrtf(ss.z * (1.0f / 256.0f) + EPS), 1.0f / sqrtf(ss.w * (1.0f / 256.0f) + EPS)};
        bf16* Ow = OAb + (size_t)(r0 + 4 * g) * 2048 + q16;
#pragma unroll
        for (int cb = 0; cb < 16; ++cb) { const f32x4 v = o[cb] * r;
            Ow[cb * 16] = (bf16)(pk2(v.x, 0.f) & 0xffffu); Ow[2048 + cb * 16] = (bf16)(pk2(v.y, 0.f) & 0xffffu); Ow[2 * 2048 + cb * 16] = (bf16)(pk2(v.z, 0.f) & 0xffffu); Ow[3 * 2048 + cb * 16] = (bf16)(pk2(v.w, 0.f) & 0xffffu); }
    }
}
}

static __device__ const unsigned char ATT_ORDER[8][128] = {
    {63,127,62,126,61,125,60,124,59,123,58,122,57,121,56,120,55,119,54,118,53,117,52,116,51,115,85,86,87,88,89,90,91,92,93,94,95,50,114,84,83,49,113,82,81,48,80,112,47,79,111,46,78,110,45,77,109,44,76,108,43,75,107,42,74,106,41,73,105,40,72,104,39,71,103,38,70,102,37,69,101,36,68,100,35,67,99,4,5,6,7,8,9,10,11,12,13,14,15,16,17,18,19,20,21,22,23,24,25,26,27,28,29,30,31,3,2,34,66,98,1,33,65,97,0,32,64,96},
    {63,127,62,126,61,125,60,124,59,123,58,122,57,121,56,120,55,119,54,118,53,117,52,116,51,115,50,114,49,113,48,112,47,111,46,110,45,109,44,108,43,107,42,106,75,76,77,78,79,80,81,82,83,84,85,86,87,88,89,90,91,92,93,94,95,41,105,74,73,40,72,104,39,71,103,38,70,102,37,69,101,6,7,8,9,10,11,12,13,14,15,16,17,18,19,20,21,22,23,24,25,26,27,28,29,30,31,5,4,36,68,100,3,35,67,99,2,34,66,98,1,33,65,97,0,32,64,96},
    {63,127,62,126,61,125,60,124,59,123,58,122,57,121,56,120,55,119,54,118,53,117,52,116,51,115,50,114,49,113,48,112,47,111,46,110,45,109,44,108,43,107,42,106,11,12,13,14,15,16,17,18,19,20,21,22,23,24,25,26,27,28,29,30,31,41,105,10,9,8,40,104,7,39,103,6,38,102,5,37,101,70,71,72,73,74,75,76,77,78,79,80,81,82,83,84,85,86,87,88,89,90,91,92,93,94,95,69,4,36,68,100,3,35,67,99,2,34,66,98,1,33,65,97,0,32,64,96},
    {63,127,62,126,61,125,60,124,59,123,58,122,57,121,56,120,55,119,54,118,53,117,52,116,51,115,21,22,23,24,25,26,27,28,29,30,31,50,114,20,19,49,113,18,17,16,48,112,15,47,111,14,46,110,13,45,109,12,44,108,11,43,107,10,42,106,9,41,105,8,40,104,7,39,103,6,38,102,5,37,101,4,36,100,3,35,99,68,69,70,71,72,73,74,75,76,77,78,79,80,81,82,83,84,85,86,87,88,89,90,91,92,93,94,95,67,2,34,66,98,1,33,65,97,0,32,64,96},
    {31,95,30,94,29,93,28,92,27,91,26,90,25,89,24,88,23,87,22,86,21,85,20,84,19,83,53,54,55,56,57,58,59,60,61,62,63,18,82,52,51,17,81,50,49,16,48,80,15,47,79,14,46,78,13,45,77,12,44,76,11,43,75,10,42,74,9,41,73,8,40,72,7,39,71,6,38,70,5,37,69,4,36,68,3,35,67,100,101,102,103,104,105,106,107,108,109,110,111,112,113,114,115,116,117,118,119,120,121,122,123,124,125,126,127,99,2,34,66,98,1,33,65,97,0,32,64,96},
    {31,95,30,94,29,93,28,92,27,91,26,90,25,89,24,88,23,87,22,86,21,85,20,84,19,83,18,82,17,81,16,80,15,79,14,78,13,77,12,76,11,75,10,74,43,44,45,46,47,48,49,50,51,52,53,54,55,56,57,58,59,60,61,62,63,9,73,42,41,8,40,72,7,39,71,6,38,70,5,37,69,102,103,104,105,106,107,108,109,110,111,112,113,114,115,116,117,118,119,120,121,122,123,124,125,126,127,101,4,36,68,100,3,35,67,99,2,34,66,98,1,33,65,97,0,32,64,96},
    {31,95,30,94,29,93,28,92,27,91,26,90,25,89,24,88,23,87,22,86,21,85,20,84,19,83,18,82,17,81,16,80,15,79,14,78,13,77,12,76,11,75,10,74,107,108,109,110,111,112,113,114,115,116,117,118,119,120,121,122,123,124,125,126,127,9,73,106,105,8,72,104,7,71,103,6,70,102,5,69,101,38,39,40,41,42,43,44,45,46,47,48,49,50,51,52,53,54,55,56,57,58,59,60,61,62,63,37,4,36,68,100,3,35,67,99,2,34,66,98,1,33,65,97,0,32,64,96},
    {31,95,30,94,29,93,28,92,27,91,26,90,25,89,24,88,23,87,22,86,21,85,20,84,19,83,117,118,119,120,121,122,123,124,125,126,127,18,82,116,115,17,81,114,113,16,80,112,15,79,111,14,78,110,13,77,109,12,76,108,11,75,107,10,74,106,9,73,105,8,72,104,7,71,103,6,70,102,5,69,101,4,68,100,3,67,99,36,37,38,39,40,41,42,43,44,45,46,47,48,49,50,51,52,53,54,55,56,57,58,59,60,61,62,63,35,2,34,66,98,1,33,65,97,0,32,64,96},
};
#ifndef WGM_G1
#define WGM_G1 4
#endif
#ifndef WGM_G3
#define WGM_G3 4
#endif
#ifndef WGM_G4
#define WGM_G4 4
#endif
#ifndef HID_PAD
#define HID_PAD 0
#endif
constexpr int HP = FF + HID_PAD;
constexpr int N_PHASES = 1 + 4 * 8 + 1 - 1 - 2;
#ifndef ATT_SD
#define ATT_SD 2
#endif
struct Params { const float* in[19]; float* out; unsigned char* ws; float lam0, lam1; int ph_lo, ph_hi, li, pad; };

__global__ void __launch_bounds__(512, 2) yoco_fwd(Params P) {
    extern __shared__ __attribute__((aligned(16))) unsigned char lds_raw[];
    LAS unsigned char* lds = (LAS unsigned char*)lds_raw;
    volatile LAS unsigned* MISC = (volatile LAS unsigned*)(lds + MISC_OFF);
    if (threadIdx.x < 128) MISC[threadIdx.x] = 0u;
    __syncthreads();
    unsigned* ctl = (unsigned*)(P.ws + WS_CTL);
    XcdBarrier bar = xcd_barrier_post(ctl + CW_BAR + P.li * XCD_BAR_WORDS, MISC + 8);
    const int lo = P.ph_lo, hi = P.ph_hi; int pc = 0;
#define PHASE_BEGIN if (pc >= lo && pc < hi) { PTRS
#define PHASE_END   if (pc + 1 < hi) xcd_barrier(bar); } ++pc;
#ifndef PROBE_MASK
#define PROBE_MASK 0
#endif
#if PROBE_MASK
#define REP_BEGIN(bit) for (int rep_ = 0, nrep_ = ((P.pad >> (bit)) & 1) + 1; rep_ < nrep_; ++rep_) {
#define REP_END if (rep_ + 1 < nrep_) xcd_barrier(bar); }
#else
#define REP_BEGIN(bit) {
#define REP_END }
#endif
#define PTRS size_t wz_ = 0; asm volatile("" : "+s"(wz_)); unsigned char* ws = P.ws + wz_; int tid = threadIdx.x; asm volatile("" : "+v"(tid)); int bx = blockIdx.x; asm volatile("" : "+s"(bx)); int G = gridDim.x; asm volatile("" : "+s"(G)); \
    const int lane = tid & 63, wave = __builtin_amdgcn_readfirstlane(tid >> 6), gw = bx * 8 + wave, ngw = G * 8; (void)lane; (void)gw; (void)ngw; \
    bf16* XB = (bf16*)(ws + WS_XB); float* RS = (float*)(ws + WS_RS); float* MB = (float*)(ws + WS_M); \
    bf16* R1 = (bf16*)(ws + WS_R1); bf16* R2 = (bf16*)(ws + WS_R2); bf16* R3 = (bf16*)(ws + WS_R3); bf16* QB = R3 + (size_t)MT * DM; \
    bf16* KpB = (bf16*)(ws + WS_KP); bf16* VpB = (bf16*)(ws + WS_VP); bf16* KsB = (bf16*)(ws + WS_KS); bf16* VsB = (bf16*)(ws + WS_VS); \
    float* Y = P.out + wz_ + OUT_Y; (void)XB; (void)RS; (void)MB; (void)R1; (void)R2; (void)R3; (void)QB; (void)KpB; (void)VpB; (void)KsB; (void)VsB; (void)Y;
#define INP(k) ({ int kk_ = (k); asm volatile("" : "+s"(kk_)); P.in[kk_]; })

    PHASE_BEGIN
    REP_BEGIN(2)
    {
#ifndef NO_P0
        LAS float* scr = (LAS float*)(lds + wave * 17408);
        tr_matrix(INP(9), DM, 6 * DM, (bf16*)(ws + WS_WIN), INP(5), DM - 1, 1.f, 2048, 4096, 0.0625f, scr, gw, ngw, lane);
        tr_matrix(INP(10), 2 * DM, DM, (bf16*)(ws + WS_WRO), nullptr, 0, 1.f, 0, 0, 1.f, scr, gw, ngw, lane);
        for (int l = 0; l < 2; ++l) {
            tr_matrix(INP(17) + (size_t)l * DM * FF, DM, FF, (bf16*)(ws + WS_WUP + l * SZ_WUP), INP(7) + l * DM, DM - 1, 1.f, 0, 0, 1.f, scr, gw, ngw, lane);
            tr_matrix(INP(18) + (size_t)l * FF * DM, FF, DM, (bf16*)(ws + WS_WDN + l * SZ_WDN), nullptr, 0, 1.f, 0, 0, 1.f, scr, gw, ngw, lane);
        }
        static_assert(256 * (SEQ / 64) * 4 * 1024 == DB * PAST * DM, "the cache K/V -> bf16 conversion rides in the retention phases (ret::Seq::cvt_src)");
        for (int r = gw; r < 2 * DB * 96; r += ngw) { const int t = r / (DB * 96), rr = r - t * (DB * 96), b = rr / 96, p = rr - b * 96;
            v4u* d = (v4u*)((t ? VsB : KsB) + ((size_t)b * SKV_S + 1056 + p) * DM) + lane;
#pragma unroll
            for (int j = 0; j < 4; ++j) d[64 * j] = (v4u){0u, 0u, 0u, 0u}; }
        for (int r = gw; r < MT; r += ngw) { const float* src = r < MP ? INP(0) + (size_t)r * DM : INP(1) + (size_t)(r - MP) * DM;
            x_init_row(src, XB + (size_t)r * DM, RS + r, lane); }
#endif
    }
    REP_END
    PHASE_END

    for (int l = 0; l < 4; ++l) {
        const bool retl = l < 2; const int j = l - 2;
        if (l != 2) {
        PHASE_BEGIN
        REP_BEGIN(0)
        if (retl) {
            pg8::Gemm g{XB, (const bf16*)(ws + WS_WIN + l * SZ_WIN), MT, 6 * DM, DM, DM};
            pg8::StaticOrder S; S.init(MT, 6 * DM, G, bx, WGM_G1);
            pg8::EpiProj E{R1, RS};
#ifndef NO_GEMM0
            pg8::gemm_phase<pg8::EpiProj, pg8::StaticOrder, true, true>(lds, g, S, E);
#endif
            { const int nwg_ = (MT / 256) * (6 * DM / 256), rem_ = nwg_ - (nwg_ / G) * G;
              if (l == 1 && rem_ > 0 && bx >= rem_) { LAS float* scr = (LAS float*)(lds + wave * 17408); const int tgw = (bx - rem_) * 8 + wave, tng = (G - rem_) * 8;
                tr_matrix(INP(10) + (size_t)2 * DM * DM, 2 * DM, DM, (bf16*)(ws + WS_WRO + SZ_WRO), nullptr, 0, 1.f, 0, 0, 1.f, scr, tgw, tng, lane); } }
        } else {
            pg8::Gemm g{XB, (const bf16*)(ws + WS_WQ + j * SZ_WQ), MT, DM, DM, DM};
            pg8::StaticOrder S; S.init(MT, DM, G, bx);
            pg8::EpiBf16Rs<0> E{QB, DM, RS};
#ifndef NO_GEMM1
            pg8::gemm_phase<pg8::EpiBf16Rs<0>, pg8::StaticOrder, true, true>(lds, g, S, E);
#endif
            { const int nwg_ = (MT / 256) * (DM / 256), rem_ = nwg_ - (nwg_ / G) * G;
              if (rem_ > 0 && bx >= rem_) { LAS float* scr = (LAS float*)(lds + wave * 17408); const int tgw = (bx - rem_) * 8 + wave, tng = (G - rem_) * 8;
                tr_matrix(INP(18) + (size_t)3 * FF * DM, FF, DM, (bf16*)(ws + WS_WDN + 3 * SZ_WDN), nullptr, 0, 1.f, 0, 0, 1.f, scr, tgw, tng, lane); } }
        }
        REP_END
        PHASE_END
        }
        PHASE_BEGIN
        REP_BEGIN(retl ? 4 : 5)
        if (retl) {
            const int vx = (G & 7) ? bx : (bx & 7) * (G >> 3) + (bx >> 3);
            for (int u = vx; u < 256 + 2048; u += G) {
                ret::Seq sq; int h, s;
                if (u < 256) { const int b = u >> 6; h = (u >> 3) & 7; s = u & 7;
                    sq.proj = R1 + (size_t)b * SEQ * 6 * DM; sq.oret = R2 + (size_t)b * SEQ * 2 * DM; sq.S0 = nullptr;
                    sq.Sout = P.out + OUT_SP + ((size_t)(l * NBP + b) * NH + h) * (DK * DV); sq.nchunks = SEQ / 64; sq.pad = 0;
                    sq.cvt_src = INP(3 + l); sq.cvt_dst = l ? VsB : KsB; sq.cvt_chunk0 = u * 256; }
                else { const int su = u - 256, b = su >> 6; h = (su >> 3) & 7; s = su & 7; const size_t row0 = (size_t)MP + b * DS;
                    sq.proj = R1 + row0 * 6 * DM; sq.oret = R2 + row0 * 2 * DM; sq.S0 = INP(2) + ((size_t)(l * DB + b) * NH + h) * (DK * DV);
                    sq.Sout = P.out + OUT_SS + ((size_t)(l * DB + b) * NH + h) * (DK * DV); sq.nchunks = 1; sq.pad = 32; sq.cvt_src = nullptr; sq.cvt_dst = nullptr; sq.cvt_chunk0 = 0; }
                const float xg = __builtin_amdgcn_exp2f((float)(-5 - h));
                const float l2g = -1.4426950408889634f * (xg * (1.f + xg * (0.5f + xg * (0.33333334f + xg * (0.25f + xg * 0.2f)))));
#ifndef NO_RET
                ret::unit(sq, h, s, l2g, lds);
#endif
            }
        } else {
            const float* dl = INP(14) + j * 512;
            const float s1 = wave_sum(dl[lane] * dl[128 + lane] + dl[64 + lane] * dl[192 + lane]);
            const float s2 = wave_sum(dl[256 + lane] * dl[384 + lane] + dl[320 + lane] * dl[448 + lane]);
            const float lam = __expf(s1) - __expf(s2) + (j ? P.lam1 : P.lam0);
#ifndef NO_ATT
            unsigned* qc = ctl + CW_ATTQ + j * 256;
            const int xq = bx & 7;
            int nxt = -1;
#define ATT_FETCH() do { if (tid == 0) { nxt = -1; unsigned i_ = atomicAdd(qc + xq * 16, 1u); \
                    if (i_ < 128u) nxt = (xq << 7) | ATT_ORDER[xq][i_]; \
                    else { i_ = atomicAdd(qc + 128, 1u); if (i_ < 256u) nxt = 1024 + (int)i_; \
                        else for (int d_ = 1; d_ < 8 && nxt < 0; ++d_) { const int y_ = (xq + d_) & 7; i_ = atomicAdd(qc + y_ * 16, 1u); if (i_ < 128u) nxt = (y_ << 7) | ATT_ORDER[y_][i_]; } } } } while (0)
            ATT_FETCH();
            for (;;) {
                if (tid == 0) MISC[16] = (unsigned)nxt;
                __syncthreads();
                const int u = (int)MISC[16];
                if (u < 0) break;
                ATT_FETCH();
                int h, b, NT, qpos0, klim; size_t row0; const bf16* Kb; const bf16* Vb; bool act; const bool prm = u < 1024;
                if (prm) { const int qb = u & 31; b = (u >> 5) & 3; h = (u >> 7) ^ (b == 0 ? 0 : b == 1 ? 7 : b == 2 ? 3 : 4);
                    row0 = (size_t)b * SEQ + qb * 128;
                    Kb = KpB + (size_t)b * SEQ * DM; Vb = VpB + (size_t)b * SEQ * DM; NT = 2 * qb + 2; qpos0 = qb * 128; klim = (2 * qb + (wave >> 2) + 1) * 64; act = true; }
                else { const int su = u - 1024; h = su & 7; b = su >> 3; row0 = (size_t)MP + b * DS;
                    Kb = KsB + (size_t)b * SKV_S * DM; Vb = VsB + (size_t)b * SKV_S * DM; NT = 18; qpos0 = PAST; klim = PAST + DS; act = (wave < 2); }
                const float nb = -__builtin_amdgcn_exp2f((float)(-(h + 1))) * 11.313708498984761f;
                if (prm) a16::attn_pair<false>(QB + row0 * DM + h * 256, Kb + h * 256, Vb + h * 256, R3 + row0 * DM + h * 256, NT, qpos0, klim, act, nb, lam, lds, ctl + CW_KMAX + (b * 16 + h * 2) * 4);
                else a16::attn_sample2(QB + row0 * DM + h * 256, Kb + h * 256, Vb + h * 256, R3 + row0 * DM + h * 256, NT, qpos0, klim, nb, lam, lds);
            }
#undef ATT_FETCH
#endif
        }
        REP_END
        PHASE_END
        if (retl) {
        PHASE_BEGIN
        REP_BEGIN(3)
        {
            static_assert((MT * NH) % 4 == 0, "gate batching");
            for (int it = gw; it < MT * NH / 4; it += ngw) {
                const bf16* o_[4]; const bf16* g_[4]; bf16* og_[4];
#pragma unroll
                for (int n = 0; n < 4; ++n) { const int id = it * 4 + n; const size_t row = id >> 3; const int h = id & 7;
                    o_[n] = R2 + row * 2 * DM + h * 512; g_[n] = R1 + row * 6 * DM + 8192 + h * 512; og_[n] = R3 + row * 2 * DM + h * 512; }
                gate_items<4>(o_, g_, og_, lane); }
        }
        REP_END
        PHASE_END
        }
        PHASE_BEGIN
        REP_BEGIN(0)
        if (retl) {
            const bf16* Bt = (const bf16*)(ws + WS_WRO + l * SZ_WRO);
            { pg8::Gemm g{R3, Bt, MP, DM, 2 * DM, 2 * DM}; pg8::StaticOrder S; S.init(MP, DM, G, bx); pg8::EpiBf16Plain E{(bf16*)MB, DM};
#ifndef NO_GEMM2
              pg8::gemm_phase<pg8::EpiBf16Plain, pg8::StaticOrder, true, true>(lds, g, S, E);
#endif
            }
            { const int ks = bx & 7; pg8::Gemm g{R3 + (size_t)MP * 2 * DM + ks * (2 * DM / 8), Bt + ks * (2 * DM / 8), MS, DM, 2 * DM / 8, 2 * DM}; pg8::SplitOrder S{G, bx}; pg8::EpiF32 E{(float*)R2 + (size_t)ks * MS * DM, DM};
#ifndef NO_GEMM2
              pg8::gemm_phase<pg8::EpiF32, pg8::SplitOrder, true, true>(lds, g, S, E);
#endif
            }
        } else {
            const bf16* Bt = (const bf16*)(ws + WS_WO + j * SZ_WQ);
            { pg8::Gemm g{R3, Bt, MP, DM, DM, DM}; pg8::StaticOrder S; S.init(MP, DM, G, bx); pg8::EpiBf16Plain E{(bf16*)MB, DM};
#ifndef NO_GEMM3
              pg8::gemm_phase<pg8::EpiBf16Plain, pg8::StaticOrder, true, true>(lds, g, S, E);
#endif
            }
            { const int ks = bx & 7; pg8::Gemm g{R3 + (size_t)MP * DM + ks * (DM / 8), Bt + ks * (DM / 8), MS, DM, DM / 8, DM}; pg8::SplitOrder S{G, bx}; pg8::EpiF32 E{(float*)R2 + (size_t)ks * MS * DM, DM};
#ifndef NO_GEMM3
              pg8::gemm_phase<pg8::EpiF32, pg8::SplitOrder, true, true>(lds, g, S, E);
#endif
            }
        }
        REP_END
        PHASE_END
        PHASE_BEGIN
        { float gv[4][8]; load_gains(gv, INP(6) + l * DM, lane);
        for (int r = gw; r < MT; r += ngw) res_row(XB + (size_t)r * DM, r < MP ? (const bf16*)MB + (size_t)r * DM : nullptr, (const float*)R2 + (size_t)(r - MP) * DM, gv, RS + r, nullptr, lane); }
        PHASE_END
        PHASE_BEGIN
        REP_BEGIN(6)
        {
            pg8::Gemm g{XB, (const bf16*)(ws + WS_WUP + l * SZ_WUP), MT, FF, DM, DM};
            pg8::StaticOrder S; S.init(MT, FF, G, bx, WGM_G3);
            pg8::EpiBf16Rs<1> E{R1, HP, RS};
#ifndef NO_GEMM4
            pg8::gemm_phase<pg8::EpiBf16Rs<1>, pg8::StaticOrder, true, true>(lds, g, S, E);
#endif
            { const int nwg_ = (MT / 256) * (FF / 256), rem_ = nwg_ - (nwg_ / G) * G;
              if (rem_ > 0 && bx >= rem_ && l < 3) { LAS float* scr = (LAS float*)(lds + wave * 17408); const int tgw = (bx - rem_) * 8 + wave, tng = (G - rem_) * 8;
                if (l == 0) {
                    tr_matrix(INP(9) + (size_t)DM * 6 * DM, DM, 6 * DM, (bf16*)(ws + WS_WIN + SZ_WIN), INP(5) + DM, DM - 1, 1.f, 2048, 4096, 0.0625f, scr, tgw, tng, lane);
                } else if (l == 1) {
                    tr_matrix(INP(12), DM, 2 * DM, (bf16*)(ws + WS_WKV), INP(11), DM - 1, 1.f, 0, 0, 1.f, scr, tgw, tng, lane);
                    for (int jj = 0; jj < 2; ++jj) {
                        tr_matrix(INP(13) + (size_t)jj * DM * DM, DM, DM, (bf16*)(ws + WS_WQ + jj * SZ_WQ), INP(5) + (2 + jj) * DM, DM - 1, 1.f, 0, 0, 1.f, scr, tgw, tng, lane);
                        tr_matrix(INP(16) + (size_t)jj * DM * DM, DM, DM, (bf16*)(ws + WS_WO + jj * SZ_WQ), INP(15) + jj * 256, 255, 1.f - (jj ? P.lam1 : P.lam0), 0, 0, 1.f, scr, tgw, tng, lane);
                    }
                } else {
                    tr_matrix(INP(17) + (size_t)3 * DM * FF, DM, FF, (bf16*)(ws + WS_WUP + 3 * SZ_WUP), INP(7) + 3 * DM, DM - 1, 1.f, 0, 0, 1.f, scr, tgw, tng, lane);
                } } }
        }
        REP_END
        PHASE_END
        PHASE_BEGIN
        REP_BEGIN(0)
        {
            const bf16* Bt = (const bf16*)(ws + WS_WDN + l * SZ_WDN);
            { pg8::Gemm g{R1, Bt, MP, DM, FF, HP, FF}; pg8::StaticOrder S; S.init(MP, DM, G, bx, WGM_G4); pg8::EpiBf16Plain E{(bf16*)MB, DM};
#ifndef NO_GEMM5
              pg8::gemm_phase<pg8::EpiBf16Plain, pg8::StaticOrder, true, true>(lds, g, S, E);
#endif
            }
            { const int ks = bx & 7; pg8::Gemm g{R1 + (size_t)MP * HP + ks * (FF / 8), Bt + ks * (FF / 8), MS, DM, FF / 8, HP, FF}; pg8::SplitOrder S{G, bx}; pg8::EpiF32 E{(float*)R2 + (size_t)ks * MS * DM, DM};
#ifndef NO_GEMM5
              pg8::gemm_phase<pg8::EpiF32, pg8::SplitOrder, true, true>(lds, g, S, E);
#endif
            }
        }
        REP_END
        PHASE_END
        PHASE_BEGIN
        { float gv[4][8]; load_gains(gv, INP(8) + l * DM, lane);
        for (int r = gw; r < MT; r += ngw) res_row(XB + (size_t)r * DM, r < MP ? (const bf16*)MB + (size_t)r * DM : nullptr, (const float*)R2 + (size_t)(r - MP) * DM, gv, RS + r, l == 3 ? Y + (size_t)r * DM : nullptr, lane); }
        PHASE_END
        if (l == 1) {
            PHASE_BEGIN
            REP_BEGIN(0)
            {
                static_assert(WS_WQ == WS_WKV + SZ_WKV, "Wkv_t and Wq_t[0] are one [6144][2048] operand");
                pg8::Gemm g{XB, (const bf16*)(ws + WS_WKV), MT, 3 * DM, DM, DM};
                pg8::StaticOrder S; S.init(MT, 3 * DM, G, bx);
                pg8::EpiKVQ E{pg8::EpiKV{P.out + OUT_KP, P.out + OUT_VP, P.out + OUT_KS, P.out + OUT_VS, KpB, VpB, KsB, VsB, RS, ctl + CW_KMAX}, pg8::EpiBf16Rs<0>{QB, DM, RS}};
#ifndef NO_GEMM6
                pg8::gemm_phase<pg8::EpiKVQ, pg8::StaticOrder, true, true>(lds, g, S, E);
#endif
                { const int nwg_ = (MT / 256) * (3 * DM / 256), rem_ = nwg_ - (nwg_ / G) * G;
                  if (rem_ > 0 && bx >= rem_) { LAS float* scr = (LAS float*)(lds + wave * 17408); const int tgw = (bx - rem_) * 8 + wave, tng = (G - rem_) * 8;
                    tr_matrix(INP(17) + (size_t)2 * DM * FF, DM, FF, (bf16*)(ws + WS_WUP + 2 * SZ_WUP), INP(7) + 2 * DM, DM - 1, 1.f, 0, 0, 1.f, scr, tgw, tng, lane);
                    tr_matrix(INP(18) + (size_t)2 * FF * DM, FF, DM, (bf16*)(ws + WS_WDN + 2 * SZ_WDN), nullptr, 0, 1.f, 0, 0, 1.f, scr, tgw, tng, lane); } }
            }
            REP_END
            PHASE_END
        }
    }
#undef PHASE_BEGIN
#undef PHASE_END
}

extern "C" void kernel_launch(void* const* d_in, const int* in_sizes, int n_in, void* d_out, int out_size, void* d_ws, size_t ws_size, hipStream_t stream) {
    static int grid = 0;
    if (grid == 0) {
        if (n_in != 19 || (size_t)out_size != OUT_END || ws_size < WS_END) { fprintf(stderr, "kernel_launch: shape mismatch: n_in %d out %d ws %zu (need %zu)\n", n_in, out_size, ws_size, (size_t)WS_END); grid = -1; return; }
        int dev = 0, cus = 0, per_cu = 0;
        if (hipGetDevice(&dev) != hipSuccess || hipDeviceGetAttribute(&cus, hipDeviceAttributeMultiprocessorCount, dev) != hipSuccess) { grid = -1; return; }
        if (hipFuncSetAttribute((const void*)yoco_fwd, hipFuncAttributeMaxDynamicSharedMemorySize, LDS_BYTES) != hipSuccess) { fprintf(stderr, "kernel_launch: hipFuncSetAttribute failed\n"); grid = -1; return; }
        if (hipOccupancyMaxActiveBlocksPerMultiprocessor(&per_cu, (const void*)yoco_fwd, 512, LDS_BYTES) != hipSuccess || per_cu < 1) { fprintf(stderr, "kernel_launch: occupancy query says %d blocks per CU\n", per_cu); }
        (void)hipGetLastError();
        grid = cus;
    }
    if (grid < 0) return;
    if (hipMemsetAsync((char*)d_ws + WS_CTL, 0, MK_PER_PHASE ? CTL_ZERO_BYTES : (size_t)(CW_BAR + XCD_BAR_WORDS) * 4, stream) != hipSuccess) { fprintf(stderr, "kernel_launch: memset failed\n"); return; }
    Params p{};
    for (int i = 0; i < 19; ++i) p.in[i] = (const float*)d_in[i];
    p.out = (float*)d_out; p.ws = (unsigned char*)d_ws;
    p.lam0 = (float)(0.8 - 0.6 * exp(-0.3 * 2.0)); p.lam1 = (float)(0.8 - 0.6 * exp(-0.3 * 3.0));
#if MK_PER_PHASE
    for (int li = 0; li < N_PHASES; ++li) { p.ph_lo = li; p.ph_hi = li + 1; p.li = li; p.pad = 0;
        hipLaunchKernelGGL(yoco_fwd, dim3(grid), dim3(512), LDS_BYTES, stream, p); }
#else
    p.ph_lo = 0; p.ph_hi = N_PHASES; p.li = 0; p.pad = PROBE_MASK;
    hipLaunchKernelGGL(yoco_fwd, dim3(grid), dim3(512), LDS_BYTES, stream, p);
#endif
    const hipError_t le = hipPeekAtLastError();
    if (le != hipSuccess) fprintf(stderr, "kernel_launch: launch failed: %s\n", hipGetErrorName(le));
}
```

```cpp
#include <hip/hip_runtime.h>
#include <hip/hip_bf16.h>
#include <cstdio>
#include <cstdint>
#include <cmath>

#ifndef MK_PER_PHASE
#define MK_PER_PHASE 0
#endif

constexpr int DM = 2048, NBP = 4, SEQ = 4096, DB = 32, DS = 32, PAST = 1024;
constexpr int MP = NBP * SEQ, MS = DB * DS, MT = MP + MS;
constexpr int NH = 8, DK = 256, DV = 512, HD = 128, FF = 8192;
constexpr int SKV_S = 1152;
constexpr float EPS = 1e-6f;
namespace pg8 {
#define PG8_LAS __attribute__((address_space(3)))
typedef unsigned short bf16_t;
typedef short bf16x8 __attribute__((ext_vector_type(8)));
typedef float f32x4 __attribute__((ext_vector_type(4)));
typedef unsigned u32x4 __attribute__((ext_vector_type(4)));
constexpr int BM = 256, BK = 64, HALF = 128, HTB = HALF * BK * 2  , STAGE_BYTES = 8 * HTB, NXCD = 8, WGM = 4;

__host__ __device__ __forceinline__ int lds_byte(int r, int c) { const int st = (r >> 4) * 2 + (c >> 5), rr = r & 15, cc = c & 31, ob = rr * 64 + cc * 2; return st * 1024 + (ob ^ (((ob >> 9) & 1) << 5)); }
__host__ __device__ __forceinline__ void stage_rc(int b, int& R, int& C) { const int st = b / 1024, sb = b % 1024, swz = sb ^ (((sb >> 9) & 1) << 5); R = (st >> 1) * 16 + swz / 64; C = (st & 1) * 32 + (swz % 64) / 2; }
__host__ __device__ __forceinline__ int perm32(int rho) { const int n = rho >> 4, i = rho & 15; return 8 * (i >> 2) + 4 * n + (i & 3); }

struct Unit { int pm, pn; };
struct Gemm { const bf16_t* A; const bf16_t* Bt; int M, N, K, ld; int ldb = -1; };

struct StaticOrder {
    int nM, nN, nwg, G, c, wgm;
    __host__ __device__ void init(int M, int N, int G_, int c_, int wgm_ = WGM) { nM = M / BM; nN = N / BM; nwg = nM * nN; G = G_; c = c_; wgm = wgm_; }
    __host__ __device__ bool next(int i, Unit& u) const {
        const long L = (long)i * G + c; if (L >= nwg) return false;
        int wgid = (int)L; { const int q = nwg / NXCD, r = nwg % NXCD, xcd = wgid % NXCD, off = wgid / NXCD; wgid = (xcd < r ? xcd * (q + 1) : r * (q + 1) + (xcd - r) * q) + off; }
        const int nig = wgm * nN, gid = wgid / nig, fm = gid * wgm, gsz = (nM - fm) < wgm ? (nM - fm) : wgm;
        u.pm = fm + ((wgid % nig) % gsz); u.pn = (wgid % nig) / gsz; return true;
    }
    __device__ __forceinline__ void a_ready(const Unit&) const {}
    __device__ __forceinline__ void done(const Unit&) const {}
};

__device__ __forceinline__ unsigned cvt_pk_bf16(float lo, float hi) { unsigned r; asm volatile("v_cvt_pk_bf16_f32 %0, %1, %2" : "=v"(r) : "v"(lo), "v"(hi)); return r; }
typedef float f32x2 __attribute__((ext_vector_type(2)));
template <int ACT> struct EpiBf16Rs {
    static constexpr bool PERM = true, AFTER_DRAIN = false;
    bf16_t* O; int ldc; const float* rs;
    __device__ __forceinline__ void operator()(const f32x4 (&acc)[2][2][4][2], const Unit& u, int wr, int wc, int fr, int fq) const {
        const int row0 = u.pm * BM + wr * 64 + fr, col0 = u.pn * BM + wc * 32 + 8 * fq;
#pragma unroll
        for (int ai = 0; ai < 2; ++ai)
#pragma unroll
            for (int m = 0; m < 4; ++m) { const int row = row0 + ai * HALF + m * 16; const float s = rs[row]; bf16_t* rowp = O + (size_t)row * ldc + col0;
#pragma unroll
                for (int bj = 0; bj < 2; ++bj) { f32x4 v0 = acc[ai][bj][m][0] * s, v1 = acc[ai][bj][m][1] * s;
                    if (ACT == 1) { const f32x4 z = (f32x4){0.f, 0.f, 0.f, 0.f}; v0 = __builtin_elementwise_max(v0, z); v1 = __builtin_elementwise_max(v1, z); v0 = v0 * v0; v1 = v1 * v1; }
                    u32x4 w; w.x = cvt_pk_bf16(v0[0], v0[1]); w.y = cvt_pk_bf16(v0[2], v0[3]); w.z = cvt_pk_bf16(v1[0], v1[1]); w.w = cvt_pk_bf16(v1[2], v1[3]);
                    *(u32x4*)(rowp + bj * HALF) = w; } }
    }
};
struct EpiProj {
    static constexpr bool PERM = true, AFTER_DRAIN = false;
    bf16_t* O; const float* rs;
    __device__ __forceinline__ void operator()(const f32x4 (&acc)[2][2][4][2], const Unit& u, int wr, int wc, int fr, int fq) const {
        const int row0 = u.pm * BM + wr * 64 + fr, col0 = u.pn * BM + wc * 32 + 8 * fq;
        float lg = 0.f;
        if (u.pn < 16) { const int h = u.pn & 7; const float xg = __builtin_amdgcn_exp2f((float)(-5 - h));
            lg = -1.4426950408889634f * (xg * (1.f + xg * (0.5f + xg * (0.33333334f + xg * (0.25f + xg * 0.2f))))); if (u.pn >= 8) lg = -lg; }
#pragma unroll
        for (int ai = 0; ai < 2; ++ai)
#pragma unroll
            for (int m = 0; m < 4; ++m) { const int row = row0 + ai * HALF + m * 16; const int pos = row < 16384 ? (row & 63) : 32 + (row & 31);
                const float s = rs[row] * __builtin_amdgcn_exp2f(lg * (float)pos); bf16_t* rowp = O + (size_t)row * 12288 + col0;
#pragma unroll
                for (int bj = 0; bj < 2; ++bj) { const f32x4 v0 = acc[ai][bj][m][0] * s, v1 = acc[ai][bj][m][1] * s;
                    u32x4 w; w.x = cvt_pk_bf16(v0[0], v0[1]); w.y = cvt_pk_bf16(v0[2], v0[3]); w.z = cvt_pk_bf16(v1[0], v1[1]); w.w = cvt_pk_bf16(v1[2], v1[3]);
                    *(u32x4*)(rowp + bj * HALF) = w; } }
    }
};
struct EpiBf16Plain {
    static constexpr bool PERM = true, AFTER_DRAIN = false;
    bf16_t* O; int ldc;
    __device__ __forceinline__ void operator()(const f32x4 (&acc)[2][2][4][2], const Unit& u, int wr, int wc, int fr, int fq) const {
        const int row0 = u.pm * BM + wr * 64 + fr, col0 = u.pn * BM + wc * 32 + 8 * fq;
#pragma unroll
        for (int ai = 0; ai < 2; ++ai)
#pragma unroll
            for (int m = 0; m < 4; ++m) { bf16_t* rowp = O + (size_t)(row0 + ai * HALF + m * 16) * ldc + col0;
#pragma unroll
                for (int bj = 0; bj < 2; ++bj) { const f32x4 v0 = acc[ai][bj][m][0], v1 = acc[ai][bj][m][1];
                    u32x4 w; w.x = cvt_pk_bf16(v0[0], v0[1]); w.y = cvt_pk_bf16(v0[2], v0[3]); w.z = cvt_pk_bf16(v1[0], v1[1]); w.w = cvt_pk_bf16(v1[2], v1[3]);
                    *(u32x4*)(rowp + bj * HALF) = w; } }
    }
};
struct EpiF32 {
    static constexpr bool PERM = false, AFTER_DRAIN = false;
    float* C; int ldc;
    __device__ __forceinline__ void operator()(const f32x4 (&acc)[2][2][4][2], const Unit& u, int wr, int wc, int fr, int fq) const {
        const int row0 = u.pm * BM + wr * 64 + fr, col0 = u.pn * BM + wc * 32 + 4 * fq;
#pragma unroll
        for (int ai = 0; ai < 2; ++ai)
#pragma unroll
            for (int m = 0; m < 4; ++m) { float* rowp = C + (size_t)(row0 + ai * HALF + m * 16) * ldc + col0;
#pragma unroll
                for (int bj = 0; bj < 2; ++bj)
#pragma unroll
                    for (int n = 0; n < 2; ++n) *(f32x4*)(rowp + bj * HALF + n * 16) = acc[ai][bj][m][n]; }
    }
};
struct EpiKV {
    static constexpr bool PERM = true, AFTER_DRAIN = false;
    float* kP; float* vP; float* kS; float* vS; bf16_t* KpB; bf16_t* VpB; bf16_t* KsB; bf16_t* VsB; const float* rs; unsigned* kmax;
    __device__ __forceinline__ void operator()(const f32x4 (&acc)[2][2][4][2], const Unit& u, int wr, int wc, int fr, int fq) const {
        const int row0 = u.pm * BM + wr * 64 + fr; const int colt = u.pn * BM; const bool isV = colt >= 2048;
        const int col0 = (colt & 2047) + wc * 32 + 8 * fq; const bool prompt = u.pm < 64; const bool trackK = prompt && !isV; float nrm[2] = {0.f, 0.f};
#pragma unroll
        for (int ai = 0; ai < 2; ++ai)
#pragma unroll
            for (int m = 0; m < 4; ++m) { const int row = row0 + ai * HALF + m * 16; const float s = rs[row];
                float* fp; bf16_t* bp;
                if (prompt) { fp = (isV ? vP : kP) + (size_t)row * 2048 + col0; bp = (isV ? VpB : KpB) + (size_t)row * 2048 + col0; }
                else { const int rr = row - 16384; fp = (isV ? vS : kS) + (size_t)rr * 2048 + col0; bp = (isV ? VsB : KsB) + ((size_t)(rr >> 5) * 1152 + 1024 + (rr & 31)) * 2048 + col0; }
#pragma unroll
                for (int bj = 0; bj < 2; ++bj) { const f32x4 v0 = acc[ai][bj][m][0] * s, v1 = acc[ai][bj][m][1] * s;
                    *(f32x4*)(fp + bj * HALF) = v0; *(f32x4*)(fp + bj * HALF + 4) = v1;
                    u32x4 w; w.x = cvt_pk_bf16(v0[0], v0[1]); w.y = cvt_pk_bf16(v0[2], v0[3]); w.z = cvt_pk_bf16(v1[0], v1[1]); w.w = cvt_pk_bf16(v1[2], v1[3]);
                    *(u32x4*)(bp + bj * HALF) = w;
                    if (trackK) { const f32x4 q0 = v0 * v0, q1 = v1 * v1; nrm[bj] = fmaxf(nrm[bj], (q0[0] + q0[1]) + (q0[2] + q0[3]) + (q1[0] + q1[1]) + (q1[2] + q1[3])); } } }
        if (trackK) {
#pragma unroll
            for (int bj = 0; bj < 2; ++bj) { float v = nrm[bj];
                v = fmaxf(v, __int_as_float(__builtin_amdgcn_update_dpp(0, __float_as_int(v), 0xB1, 0xF, 0xF, true)));
                v = fmaxf(v, __int_as_float(__builtin_amdgcn_update_dpp(0, __float_as_int(v), 0x4E, 0xF, 0xF, true)));
                v = fmaxf(v, __int_as_float(__builtin_amdgcn_update_dpp(0, __float_as_int(v), 0x141, 0xF, 0xF, true)));
                v = fmaxf(v, __int_as_float(__builtin_amdgcn_update_dpp(0, __float_as_int(v), 0x140, 0xF, 0xF, true)));
                { auto rr = __builtin_amdgcn_permlane16_swap(__float_as_uint(v), __float_as_uint(v), false, false); v = __uint_as_float(rr[0]) + __uint_as_float(rr[1]); }
                { auto rr = __builtin_amdgcn_permlane32_swap(__float_as_uint(v), __float_as_uint(v), false, false); v = __uint_as_float(rr[0]) + __uint_as_float(rr[1]); }
                if (fr == 0 && fq == 0) atomicMax(kmax + (((u.pm >> 4) * 16 + u.pn * 2 + bj) * 4 + wc), __float_as_uint(v)); }
        }
    }
};

struct EpiKVQ {
    static constexpr bool PERM = true, AFTER_DRAIN = false;
    EpiKV kv; EpiBf16Rs<0> q;
    __device__ __forceinline__ void operator()(const f32x4 (&acc)[2][2][4][2], const Unit& u, int wr, int wc, int fr, int fq) const {
        if (u.pn < 16) kv(acc, u, wr, wc, fr, fq);
        else { Unit v = u; v.pn = u.pn - 16; q(acc, v, wr, wc, fr, fq); }
    }
};
struct SplitOrder {
    int G, c;
    __device__ __forceinline__ bool next(int i, Unit& u) const { const int item = c + i * G; if (item >= 256) return false; const int t = item >> 3; u.pm = t >> 3; u.pn = t & 7; return true; }
    __device__ __forceinline__ void a_ready(const Unit&) const {}
    __device__ __forceinline__ void done(const Unit&) const {}
};

template <class Epi, class Sched, bool ALIGN_EPI = false, bool SP2 = false>
__device__ __forceinline__ void gemm_phase(PG8_LAS unsigned char* lds, const Gemm g, const Sched& S, const Epi& E) {
    int tid = threadIdx.x; asm volatile("" : "+v"(tid));
    const int wid = __builtin_amdgcn_readfirstlane(tid >> 6), lane = tid & 63, wr = wid >> 2, wc = wid & 3, fr = lane & 15, fq = lane >> 4;
    const int K = g.K, nt = K / BK;
    const int ldb_ = g.ldb < 0 ? g.ld : g.ldb;
    unsigned voffA[2], voffB[2];
#pragma unroll
    for (int i = 0; i < 2; ++i) { int R, C; stage_rc(tid * 16 + i * 8192, R, C); const int Rb = Epi::PERM ? ((R & ~31) + perm32(R & 31)) : R;
        voffA[i] = (unsigned)(R * g.ld + C) * 2u; voffB[i] = (unsigned)(Rb * ldb_ + C) * 2u; }
    const size_t kstep = (size_t)(BK * 2);
    const size_t hstep = (size_t)HALF * g.ld * 2;
    const size_t tstep = 2 * hstep; const size_t hstepB = (size_t)HALF * ldb_ * 2, tstepB = 2 * hstepB;
    const unsigned ldsw = (unsigned)wid * 1024u;
    const int aoff = lds_byte(wr * 64 + fr, fq * 8), boff = lds_byte(wc * 32 + fr, fq * 8);
#define PG8_SA(b, h) (((b) * 2 + (h)) * HTB)
#define PG8_SB(b, h) ((4 + (b) * 2 + (h)) * HTB)
#define PG8_STAGE(bufoff, gbase, voff) do { _Pragma("unroll") for (int _i = 0; _i < 2; ++_i) \
        __builtin_amdgcn_global_load_lds((const unsigned*)((const char*)(gbase) + (voff)[_i]), (PG8_LAS unsigned*)(lds + (bufoff) + ldsw + _i * 8192), 16, 0, 0); } while (0)
#define PG8_LDA(dst, b, h) do { _Pragma("unroll") for (int m = 0; m < 4; ++m) _Pragma("unroll") for (int k = 0; k < 2; ++k) dst[m][k] = *(const PG8_LAS bf16x8*)(lds + PG8_SA(b, h) + aoff + m * 2048 + k * 1024); } while (0)
#define PG8_LDB(dst, b, h) do { _Pragma("unroll") for (int n = 0; n < 2; ++n) _Pragma("unroll") for (int k = 0; k < 2; ++k) dst[n][k] = *(const PG8_LAS bf16x8*)(lds + PG8_SB(b, h) + boff + n * 2048 + k * 1024); } while (0)
#define PG8_MMA(ai, bj, At, Bt) do { __builtin_amdgcn_s_setprio(1); _Pragma("unroll") for (int m = 0; m < 4; ++m) _Pragma("unroll") for (int n = 0; n < 2; ++n) _Pragma("unroll") for (int k = 0; k < 2; ++k) \
        acc[ai][bj][m][n] = __builtin_amdgcn_mfma_f32_16x16x32_bf16(Bt[n][k], At[m][k], acc[ai][bj][m][n], 0, 0, 0); __builtin_amdgcn_s_setprio(0); } while (0)
#define PG8_WAIT_V(n) asm volatile("s_waitcnt vmcnt(" #n ")" ::: "memory")
#define PG8_WAIT_L(n) asm volatile("s_waitcnt lgkmcnt(" #n ")" ::: "memory")
#define PG8_BAR __builtin_amdgcn_s_barrier()
#define PG8_SCHED __builtin_amdgcn_sched_barrier(0)
    Unit cur, nxt; int ui = 0;
    if (!S.next(0, cur)) return;
    f32x4 acc[2][2][4][2];
#pragma unroll
    for (int a = 0; a < 2; ++a)
#pragma unroll
        for (int b = 0; b < 2; ++b)
#pragma unroll
            for (int m = 0; m < 4; ++m)
#pragma unroll
                for (int n = 0; n < 2; ++n) acc[a][b][m][n] = (f32x4){0.f, 0.f, 0.f, 0.f};
    bf16x8 At[4][2], B0[2][2], B1[2][2];
    const char* cA = (const char*)g.A + (size_t)cur.pm * tstep; const char* cB = (const char*)g.Bt + (size_t)cur.pn * tstepB;
    S.a_ready(cur);
    if constexpr (SP2) {
        PG8_STAGE(PG8_SB(0, 0), cB, voffB); PG8_STAGE(PG8_SB(0, 1), cB + hstepB, voffB); PG8_STAGE(PG8_SA(0, 0), cA, voffA); PG8_STAGE(PG8_SA(0, 1), cA + hstep, voffA);
        if (wr == 1) PG8_BAR;
        PG8_WAIT_V(2); PG8_BAR;
        PG8_STAGE(PG8_SB(1, 0), cB + kstep, voffB); PG8_STAGE(PG8_SA(1, 0), cA + kstep, voffA); PG8_STAGE(PG8_SB(1, 1), cB + hstepB + kstep, voffB);
        PG8_WAIT_V(6); PG8_BAR;
    } else {
        PG8_STAGE(PG8_SB(0, 0), cB, voffB); PG8_STAGE(PG8_SA(0, 0), cA, voffA); PG8_STAGE(PG8_SB(0, 1), cB + hstepB, voffB); PG8_STAGE(PG8_SA(0, 1), cA + hstep, voffA);
        if (wr == 1) PG8_BAR;
        PG8_WAIT_V(4); PG8_BAR;
        PG8_STAGE(PG8_SB(1, 0), cB + kstep, voffB); PG8_STAGE(PG8_SA(1, 0), cA + kstep, voffA); PG8_STAGE(PG8_SB(1, 1), cB + hstepB + kstep, voffB);
        PG8_WAIT_V(6); PG8_BAR;
    }
    for (;;) {
        const bool has_next = S.next(ui + 1, nxt);
        const char* nA = has_next ? (const char*)g.A + (size_t)nxt.pm * tstep : cA; const char* nB = has_next ? (const char*)g.Bt + (size_t)nxt.pn * tstepB : cB;
        for (int t = 0; t < nt; t += 2) {
            const bool last = (t == nt - 2);
            const char* a1 = cA + (size_t)(t + 1) * kstep;
            const char* a2 = last ? nA : cA + (size_t)(t + 2) * kstep; const char* b2 = last ? nB : cB + (size_t)(t + 2) * kstep;
            const char* a3 = a2 + kstep; const char* b3 = b2 + kstep;
            if (last && has_next) S.a_ready(nxt);
            if constexpr (SP2) {
            PG8_LDB(B0, 0, 0); PG8_LDB(B1, 0, 1); PG8_SCHED; PG8_LDA(At, 0, 0); PG8_STAGE(PG8_SA(1, 1), a1 + hstep, voffA);
            PG8_WAIT_V(8); PG8_WAIT_L(0); PG8_BAR; PG8_MMA(0, 0, At, B0); PG8_MMA(0, 1, At, B1); PG8_BAR; PG8_SCHED;
            PG8_LDA(At, 0, 1); PG8_STAGE(PG8_SB(0, 0), b2, voffB); PG8_STAGE(PG8_SB(0, 1), b2 + hstepB, voffB); PG8_STAGE(PG8_SA(0, 0), a2, voffA);
            PG8_WAIT_V(8); PG8_WAIT_L(0); PG8_BAR; PG8_MMA(1, 0, At, B0); PG8_MMA(1, 1, At, B1); PG8_BAR; PG8_SCHED;
            PG8_LDB(B0, 1, 0); PG8_LDB(B1, 1, 1); PG8_SCHED; PG8_LDA(At, 1, 0); PG8_STAGE(PG8_SA(0, 1), a2 + hstep, voffA);
            PG8_WAIT_V(8); PG8_WAIT_L(0); PG8_BAR; PG8_MMA(0, 0, At, B0); PG8_MMA(0, 1, At, B1); PG8_BAR; PG8_SCHED;
            PG8_LDA(At, 1, 1); PG8_STAGE(PG8_SB(1, 0), b3, voffB); PG8_STAGE(PG8_SB(1, 1), b3 + hstepB, voffB); PG8_STAGE(PG8_SA(1, 0), a3, voffA);
            PG8_WAIT_V(8); PG8_WAIT_L(0); PG8_BAR; PG8_MMA(1, 0, At, B0); PG8_MMA(1, 1, At, B1); PG8_BAR; PG8_SCHED;
            } else {
            PG8_LDB(B0, 0, 0); PG8_SCHED; PG8_LDA(At, 0, 0); PG8_STAGE(PG8_SA(1, 1), a1 + hstep, voffA);
            PG8_WAIT_L(8); PG8_BAR; PG8_WAIT_L(0); PG8_MMA(0, 0, At, B0); PG8_BAR; PG8_SCHED;
            PG8_LDB(B1, 0, 1); PG8_STAGE(PG8_SB(0, 0), b2, voffB);
            PG8_BAR; PG8_WAIT_L(0); PG8_MMA(0, 1, At, B1); PG8_BAR;
            PG8_LDA(At, 0, 1); PG8_STAGE(PG8_SA(0, 0), a2, voffA);
            PG8_BAR; PG8_WAIT_L(0); PG8_MMA(1, 0, At, B0); PG8_BAR; PG8_SCHED;
            PG8_STAGE(PG8_SB(0, 1), b2 + hstepB, voffB);
            PG8_WAIT_V(6); PG8_BAR; PG8_MMA(1, 1, At, B1); PG8_BAR;
            PG8_LDB(B0, 1, 0); PG8_SCHED; PG8_LDA(At, 1, 0); PG8_STAGE(PG8_SA(0, 1), a2 + hstep, voffA);
            PG8_WAIT_L(8); PG8_BAR; PG8_WAIT_L(0); PG8_MMA(0, 0, At, B0); PG8_BAR; PG8_SCHED;
            PG8_LDB(B1, 1, 1); PG8_STAGE(PG8_SB(1, 0), b3, voffB);
            PG8_BAR; PG8_WAIT_L(0); PG8_MMA(0, 1, At, B1); PG8_BAR;
            PG8_LDA(At, 1, 1); PG8_STAGE(PG8_SA(1, 0), a3, voffA);
            PG8_BAR; PG8_WAIT_L(0); PG8_MMA(1, 0, At, B0); PG8_BAR; PG8_SCHED;
            PG8_STAGE(PG8_SB(1, 1), b3 + hstepB, voffB);
            PG8_WAIT_V(6); PG8_BAR; PG8_MMA(1, 1, At, B1); PG8_BAR;
            }
        }
        if constexpr (ALIGN_EPI) { if (wr == 0) PG8_BAR; }
        if constexpr (!Epi::AFTER_DRAIN) { E(acc, cur, wr, wc, fr, fq); S.done(cur); }
        if (!has_next) break;
#pragma unroll
        for (int a = 0; a < 2; ++a)
#pragma unroll
            for (int b = 0; b < 2; ++b)
#pragma unroll
                for (int m = 0; m < 4; ++m)
#pragma unroll
                    for (int n = 0; n < 2; ++n) acc[a][b][m][n] = (f32x4){0.f, 0.f, 0.f, 0.f};
        cur = nxt; cA = nA; cB = nB; ++ui;
        if constexpr (ALIGN_EPI) { if (wr == 1) PG8_BAR; }
    }
    PG8_WAIT_V(0);
    if constexpr (!ALIGN_EPI) { if (wr == 0) PG8_BAR; }
    PG8_BAR;
    if constexpr (Epi::AFTER_DRAIN) { E.fused(acc, cur, wr, wc, fr, fq, lds, wid, lane); S.done(cur); }
#undef PG8_SA
#undef PG8_SB
#undef PG8_STAGE
#undef PG8_LDA
#undef PG8_LDB
#undef PG8_MMA
#undef PG8_WAIT_V
#undef PG8_WAIT_L
#undef PG8_BAR
#undef PG8_SCHED
}
}
constexpr size_t WS_CTL = 0, CTL_ZERO_BYTES = 1u << 20;
constexpr size_t SZ_WIN = (size_t)DM * 6 * DM * 2, SZ_WRO = (size_t)2 * DM * DM * 2, SZ_WUP = (size_t)DM * FF * 2, SZ_WDN = SZ_WUP, SZ_WKV = (size_t)DM * 2 * DM * 2, SZ_WQ = (size_t)DM * DM * 2;
constexpr size_t WS_WIN = CTL_ZERO_BYTES, WS_WRO = WS_WIN + 2 * SZ_WIN, WS_WUP = WS_WRO + 2 * SZ_WRO, WS_WDN = WS_WUP + 4 * SZ_WUP, WS_WKV = WS_WDN + 4 * SZ_WDN,
                 WS_WQ = WS_WKV + SZ_WKV, WS_WO = WS_WQ + 2 * SZ_WQ;
constexpr size_t WS_XB = WS_WO + 2 * SZ_WQ;
constexpr size_t WS_RS = WS_XB + (size_t)MT * DM * 2;
constexpr size_t WS_M = WS_RS + (size_t)MT * 4;
constexpr size_t WS_R1 = WS_M + (size_t)MT * DM * 4;
constexpr size_t WS_R2 = WS_R1 + (size_t)MT * 6 * DM * 2;
constexpr size_t WS_R3 = WS_R2 + (size_t)MT * 2 * DM * 2;
constexpr size_t WS_KP = WS_R3 + (size_t)MT * 2 * DM * 2;
constexpr size_t WS_VP = WS_KP + (size_t)MP * DM * 2, WS_KS = WS_VP + (size_t)MP * DM * 2, WS_VS = WS_KS + (size_t)DB * SKV_S * DM * 2;
constexpr size_t WS_END = WS_VS + (size_t)DB * SKV_S * DM * 2;
constexpr int CW_KMAX = 1024;
constexpr int CW_ATTQ = 2048;
constexpr int CW_BAR = 4096;
constexpr size_t OUT_Y = 0, OUT_SP = (size_t)MT * DM, SZ_ST = (size_t)NH * DK * DV, OUT_KP = OUT_SP + (size_t)2 * NBP * SZ_ST, OUT_VP = OUT_KP + (size_t)MP * DM,
                 OUT_SS = OUT_VP + (size_t)MP * DM, OUT_KS = OUT_SS + (size_t)2 * DB * SZ_ST, OUT_VS = OUT_KS + (size_t)MS * DM, OUT_END = OUT_VS + (size_t)MS * DM;

constexpr int LDS_MAIN = 161792;
constexpr int MISC_OFF = LDS_MAIN, LDS_BYTES = LDS_MAIN + 512;

#define GAS __attribute__((address_space(1)))
#define LAS __attribute__((address_space(3)))
typedef unsigned short bf16;
typedef unsigned v4u __attribute__((ext_vector_type(4)));
typedef unsigned v2u __attribute__((ext_vector_type(2)));
typedef float f32x4 __attribute__((ext_vector_type(4)));
typedef float f32x16 __attribute__((ext_vector_type(16)));
typedef short bf16x8 __attribute__((ext_vector_type(8)));
typedef short s16x4 __attribute__((ext_vector_type(4)));
__device__ __forceinline__ unsigned pk2(float lo, float hi) { unsigned r; asm volatile("v_cvt_pk_bf16_f32 %0, %1, %2" : "=v"(r) : "v"(lo), "v"(hi)); return r; }
__device__ __forceinline__ float bflo(unsigned w) { return __uint_as_float(w << 16); }
__device__ __forceinline__ float bfhi(unsigned w) { return __uint_as_float(w & 0xffff0000u); }
__device__ __forceinline__ float wave_sum(float v) {
    v += __int_as_float(__builtin_amdgcn_update_dpp(0, __float_as_int(v), 0xB1, 0xF, 0xF, true));
    v += __int_as_float(__builtin_amdgcn_update_dpp(0, __float_as_int(v), 0x4E, 0xF, 0xF, true));
    v += __int_as_float(__builtin_amdgcn_update_dpp(0, __float_as_int(v), 0x141, 0xF, 0xF, true));
    v += __int_as_float(__builtin_amdgcn_update_dpp(0, __float_as_int(v), 0x140, 0xF, 0xF, true));
    { auto rr = __builtin_amdgcn_permlane16_swap(__float_as_uint(v), __float_as_uint(v), false, false); v = __uint_as_float(rr[0]) + __uint_as_float(rr[1]); }
    { auto rr = __builtin_amdgcn_permlane32_swap(__float_as_uint(v), __float_as_uint(v), false, false); v = __uint_as_float(rr[0]) + __uint_as_float(rr[1]); }
    return v;
}
__device__ __forceinline__ int crow(int r, int hi) { return (r & 3) + 8 * (r >> 2) + 4 * hi; }

template <int OFF> __device__ __forceinline__ bf16x8 lds_rd128(int a) { bf16x8 r; asm volatile("ds_read_b128 %0, %1 offset:%2" : "=&v"(r) : "v"(a), "i"(OFF) : "memory"); return r; }
template <int OFF> __device__ __forceinline__ s16x4 lds_tr64(int a) { s16x4 r; asm volatile("ds_read_b64_tr_b16 %0, %1 offset:%2" : "=&v"(r) : "v"(a), "i"(OFF) : "memory"); return r; }
#define LDS_WAIT_SB(n) do { asm volatile("s_waitcnt lgkmcnt(" #n ")" ::: "memory"); __builtin_amdgcn_sched_barrier(0); } while (0)

#define XB_TMO      128
#define XB_XCNT(j)  (256  + 64 * (j))
#define XB_XSUB(j)  (1280 + 64 * (j))
#define XB_XGEN(j)  (2304 + 64 * (j))
#define XB_TOP      3328
#define XB_TOPGEN   3392
#define XCD_BAR_WORDS 3456
#define XB_SPIN_CAP (1u << 18)

__device__ __forceinline__ unsigned xb_ld(unsigned* p)              { return __hip_atomic_load(p, __ATOMIC_RELAXED, __HIP_MEMORY_SCOPE_AGENT); }
__device__ __forceinline__ unsigned xb_add(unsigned* p, unsigned v) { return __hip_atomic_fetch_add(p, v, __ATOMIC_RELAXED, __HIP_MEMORY_SCOPE_AGENT); }
__device__ __forceinline__ unsigned xb_xcc_id() { return (unsigned)__builtin_amdgcn_s_getreg((3 << 11) | 20) & 0xFu; }
#define XB_SPIN(cond, bar) do { unsigned _sp = 0; while (cond) { __builtin_amdgcn_s_sleep(1); \
    if ((++_sp & 255u) == 0u) { if (xb_ld(&(bar)[XB_TMO])) break; if (_sp > XB_SPIN_CAP) { atomicAdd(&(bar)[XB_TMO], 1u); break; } } } } while (0)

struct XcdBarrier {
    unsigned* bar; unsigned x;
    volatile LAS unsigned* st;
};

__device__ __forceinline__ XcdBarrier xcd_barrier_post(unsigned* bar, volatile LAS unsigned* st) {
    XcdBarrier b; b.bar = bar; b.x = xb_xcc_id(); b.st = st;
    if (threadIdx.x == 0) (void)xb_add(&bar[XB_XCNT(b.x)], 1u);
    return b;
}
__device__ __forceinline__ void xcd_barrier_complete(unsigned* bar, unsigned x, unsigned& nloc, unsigned& nx) {
    const unsigned G = gridDim.x * gridDim.y * gridDim.z;
    unsigned sum, cnt, mine, sp = 0u;
    for (;;) {
        sum = 0u; cnt = 0u; mine = 0u;
#pragma unroll
        for (unsigned j = 0; j < 16; ++j) { const unsigned c = xb_ld(&bar[XB_XCNT(j)]); sum += c; cnt += (c > 0u) ? 1u : 0u; mine = (j == x) ? c : mine; }
        if (sum == G) break;
        __builtin_amdgcn_s_sleep(1);
        if ((++sp & 255u) == 0u) { if (xb_ld(&bar[XB_TMO])) break; if (sp > XB_SPIN_CAP) { atomicAdd(&bar[XB_TMO], 1u); break; } }
    }
    nloc = mine > 0u ? mine : 1u; nx = cnt > 0u ? cnt : 1u;
}

__device__ __forceinline__ void xcd_barrier(const XcdBarrier& b) {
    asm volatile("s_waitcnt vmcnt(0)" ::: "memory");
    __syncthreads();
    if (threadIdx.x == 0) {
        unsigned* bar = b.bar;
        __builtin_amdgcn_s_waitcnt(0);
        unsigned nloc = b.st[0], nx = b.st[1];
        if (nloc == 0u) { xcd_barrier_complete(bar, b.x, nloc, nx); b.st[0] = nloc; b.st[1] = nx; }
        const unsigned old = xb_add(&bar[XB_XSUB(b.x)], 1u);
        const unsigned gen = old / nloc;
        if (old + 1u == (gen + 1u) * nloc) {
            __builtin_amdgcn_fence(__ATOMIC_RELEASE, "agent");
            asm volatile("s_waitcnt vmcnt(0)" ::: "memory");
            const unsigned og = xb_add(&bar[XB_TOP], 1u);
            const unsigned tg = og / nx;
            if (og + 1u == (tg + 1u) * nx) xb_add(&bar[XB_TOPGEN], 1u);
            else XB_SPIN(xb_ld(&bar[XB_TOPGEN]) == tg, bar);
            __builtin_amdgcn_fence(__ATOMIC_ACQUIRE, "agent");
            xb_add(&bar[XB_XGEN(b.x)], 1u);
            asm volatile("s_waitcnt vmcnt(0)" ::: "memory");
        } else {
            XB_SPIN(xb_ld(&bar[XB_XGEN(b.x)]) == gen, bar);
            __builtin_amdgcn_fence(__ATOMIC_ACQUIRE, "agent");
            asm volatile("s_waitcnt vmcnt(0)" ::: "memory");
        }
    }
    __syncthreads();
}
__device__ __forceinline__ void tr_matrix(const float* __restrict__ W, int K, int N, bf16* __restrict__ WT, const float* __restrict__ gk, int gmask, float gscale,
                                          int cs_lo, int cs_hi, float cs, LAS float* scr, int gw, int ngw, int lane) {
    const int nblk = N / 64, nitems = (K / 64) * nblk;
    for (int it = gw; it < nitems; it += ngw) {
        const int kb = it / nblk, nb = it - kb * nblk, k0 = 64 * kb, n0 = 64 * nb;
        const float csf = (n0 >= cs_lo && n0 < cs_hi) ? cs * gscale : gscale;
        const int r4 = lane >> 4, c4 = (lane & 15) * 4;
#pragma unroll
        for (int half = 0; half < 2; ++half) {
            f32x4 v[8]; float g[8];
#pragma unroll
            for (int i = 0; i < 8; ++i) { const int kk = (half * 8 + i) * 4 + r4; v[i] = *(const f32x4*)(W + (size_t)(k0 + kk) * N + n0 + c4); g[i] = gk ? gk[(k0 + kk) & gmask] * csf : csf; }
#pragma unroll
            for (int i = 0; i < 8; ++i) { const int kk = (half * 8 + i) * 4 + r4; *(LAS f32x4*)(scr + kk * 68 + c4) = v[i] * g[i]; }
        }
        asm volatile("s_waitcnt lgkmcnt(0)" ::: "memory");
        bf16* orow = WT + (size_t)(n0 + lane) * K + k0;
#pragma unroll
        for (int c = 0; c < 8; ++c) { v4u o;
            o.x = pk2(scr[(8 * c + 0) * 68 + lane], scr[(8 * c + 1) * 68 + lane]); o.y = pk2(scr[(8 * c + 2) * 68 + lane], scr[(8 * c + 3) * 68 + lane]);
            o.z = pk2(scr[(8 * c + 4) * 68 + lane], scr[(8 * c + 5) * 68 + lane]); o.w = pk2(scr[(8 * c + 6) * 68 + lane], scr[(8 * c + 7) * 68 + lane]);
            *(v4u*)(orow + 8 * c) = o; }
        asm volatile("s_waitcnt lgkmcnt(0)" ::: "memory");
    }
}
__device__ __forceinline__ void cvt_row(const float* __restrict__ src, bf16* __restrict__ dst, int lane) {
    const f32x4* s = (const f32x4*)src + lane; v2u* d = (v2u*)dst + lane;
#pragma unroll
    for (int j = 0; j < 8; ++j) { const f32x4 v = s[64 * j]; v2u o; o.x = pk2(v.x, v.y); o.y = pk2(v.z, v.w); d[64 * j] = o; }
}
__device__ __forceinline__ void x_init_row(const float* __restrict__ src, bf16* __restrict__ xb, float* __restrict__ rs, int lane) {
    const f32x4* s = (const f32x4*)src + lane; v2u* d = (v2u*)xb + lane; float ss = 0.f;
#pragma unroll
    for (int j = 0; j < 8; ++j) { const f32x4 v = s[64 * j]; ss += (v.x * v.x + v.y * v.y) + (v.z * v.z + v.w * v.w); v2u o; o.x = pk2(v.x, v.y); o.y = pk2(v.z, v.w); d[64 * j] = o; }
    ss = wave_sum(ss);
    if (lane == 0) *rs = 1.0f / sqrtf(ss * (1.0f / DM) + EPS);
}
__device__ __forceinline__ void res_row(bf16* __restrict__ xb, const bf16* __restrict__ mb, const float* __restrict__ ms, const float (&gv)[4][8], float* __restrict__ rs, float* __restrict__ y, int lane) {
    float mv[4][8]; float sm = 0.f;
    if (mb) {
#pragma unroll
        for (int j = 0; j < 4; ++j) { const v4u w = *((const v4u*)mb + lane + 64 * j);
            mv[j][0] = bflo(w.x); mv[j][1] = bfhi(w.x); mv[j][2] = bflo(w.y); mv[j][3] = bfhi(w.y); mv[j][4] = bflo(w.z); mv[j][5] = bfhi(w.z); mv[j][6] = bflo(w.w); mv[j][7] = bfhi(w.w); }
    } else {
#pragma unroll
        for (int j = 0; j < 4; ++j) { const f32x4* p = (const f32x4*)ms + 2 * (lane + 64 * j); f32x4 a[8], b[8];
#pragma unroll
            for (int sl = 0; sl < 8; ++sl) { a[sl] = p[(size_t)sl * (MS * DM / 4)]; b[sl] = p[(size_t)sl * (MS * DM / 4) + 1]; }
            const f32x4 as = ((a[0] + a[1]) + (a[2] + a[3])) + ((a[4] + a[5]) + (a[6] + a[7])), bs = ((b[0] + b[1]) + (b[2] + b[3])) + ((b[4] + b[5]) + (b[6] + b[7]));
            mv[j][0] = as.x; mv[j][1] = as.y; mv[j][2] = as.z; mv[j][3] = as.w; mv[j][4] = bs.x; mv[j][5] = bs.y; mv[j][6] = bs.z; mv[j][7] = bs.w; }
    }
#pragma unroll
    for (int j = 0; j < 4; ++j)
#pragma unroll
        for (int e = 0; e < 8; ++e) sm += mv[j][e] * mv[j][e];
    sm = wave_sum(sm);
    const float rm = 1.0f / sqrtf(sm * (1.0f / DM) + EPS); float sx = 0.f;
#pragma unroll
    for (int j = 0; j < 4; ++j) { const int c = lane + 64 * j; const v4u xw = *((const v4u*)xb + c);
        float xv[8] = {bflo(xw.x), bfhi(xw.x), bflo(xw.y), bfhi(xw.y), bflo(xw.z), bfhi(xw.z), bflo(xw.w), bfhi(xw.w)};
#pragma unroll
        for (int e = 0; e < 8; ++e) { xv[e] = xv[e] + mv[j][e] * gv[j][e] * rm; }
        v4u o; o.x = pk2(xv[0], xv[1]); o.y = pk2(xv[2], xv[3]); o.z = pk2(xv[4], xv[5]); o.w = pk2(xv[6], xv[7]);
        *((v4u*)xb + c) = o;
        if (y) { *((f32x4*)y + 2 * c) = (f32x4){xv[0], xv[1], xv[2], xv[3]}; *((f32x4*)y + 2 * c + 1) = (f32x4){xv[4], xv[5], xv[6], xv[7]}; }
        const float r0 = bflo(o.x), r1 = bfhi(o.x), r2 = bflo(o.y), r3 = bfhi(o.y), r4 = bflo(o.z), r5 = bfhi(o.z), r6 = bflo(o.w), r7 = bfhi(o.w);
        sx += (r0 * r0 + r1 * r1) + (r2 * r2 + r3 * r3) + (r4 * r4 + r5 * r5) + (r6 * r6 + r7 * r7); }
    sx = wave_sum(sx);
    if (lane == 0) *rs = 1.0f / sqrtf(sx * (1.0f / DM) + EPS);
}
__device__ __forceinline__ void load_gains(float (&gv)[4][8], const float* __restrict__ gpost, int lane) {
#pragma unroll
    for (int j = 0; j < 4; ++j) { const int c = lane + 64 * j; const f32x4 g0 = *((const f32x4*)gpost + 2 * c), g1 = *((const f32x4*)gpost + 2 * c + 1);
        gv[j][0] = g0.x; gv[j][1] = g0.y; gv[j][2] = g0.z; gv[j][3] = g0.w; gv[j][4] = g1.x; gv[j][5] = g1.y; gv[j][6] = g1.z; gv[j][7] = g1.w; }
}
__device__ __forceinline__ void gate_item(const bf16* __restrict__ o, const bf16* __restrict__ g, bf16* __restrict__ og, int lane) {
    const v4u ov = *((const v4u*)o + lane), gv = *((const v4u*)g + lane);
    float of[8] = {bflo(ov.x), bfhi(ov.x), bflo(ov.y), bfhi(ov.y), bflo(ov.z), bfhi(ov.z), bflo(ov.w), bfhi(ov.w)};
    float gf[8] = {bflo(gv.x), bfhi(gv.x), bflo(gv.y), bfhi(gv.y), bflo(gv.z), bfhi(gv.z), bflo(gv.w), bfhi(gv.w)};
    float ss = 0.f;
#pragma unroll
    for (int i = 0; i < 8; ++i) ss += of[i] * of[i];
    ss = wave_sum(ss);
    const float r = 1.0f / sqrtf(ss * (1.0f / DV) + EPS);
#pragma unroll
    for (int i = 0; i < 8; ++i) { const float s = gf[i] / (1.0f + __expf(-gf[i])); of[i] = s * of[i] * r; }
    v4u w; w.x = pk2(of[0], of[1]); w.y = pk2(of[2], of[3]); w.z = pk2(of[4], of[5]); w.w = pk2(of[6], of[7]);
    *((v4u*)og + lane) = w;
}
__device__ __forceinline__ void comb_item(const bf16* __restrict__ ao, bf16* __restrict__ oa, float lam, int lane) {
    const int vhalf = lane >> 5, e = (lane & 31) * 4;
    const v2u a = *(const v2u*)(ao + vhalf * 128 + e), b = *(const v2u*)(ao + (2 + vhalf) * 128 + e);
    float v[4] = {bflo(a.x) - lam * bflo(b.x), bfhi(a.x) - lam * bfhi(b.x), bflo(a.y) - lam * bflo(b.y), bfhi(a.y) - lam * bfhi(b.y)};
    float ss = (v[0] * v[0] + v[1] * v[1]) + (v[2] * v[2] + v[3] * v[3]);
    ss = wave_sum(ss);
    const float r = 1.0f / sqrtf(ss * (1.0f / 256.0f) + EPS);
    v2u w; w.x = pk2(v[0] * r, v[1] * r); w.y = pk2(v[2] * r, v[3] * r);
    *(v2u*)(oa + vhalf * 128 + e) = w;
}

template <int NB>
__device__ __forceinline__ void gate_items(const bf16* const (&o)[NB], const bf16* const (&g)[NB], bf16* const (&og)[NB], int lane) {
    v4u ov[NB], gv[NB];
#pragma unroll
    for (int n = 0; n < NB; ++n) { ov[n] = *((const v4u*)o[n] + lane); gv[n] = *((const v4u*)g[n] + lane); }
#pragma unroll
    for (int n = 0; n < NB; ++n) {
        float of[8] = {bflo(ov[n].x), bfhi(ov[n].x), bflo(ov[n].y), bfhi(ov[n].y), bflo(ov[n].z), bfhi(ov[n].z), bflo(ov[n].w), bfhi(ov[n].w)};
        float gf[8] = {bflo(gv[n].x), bfhi(gv[n].x), bflo(gv[n].y), bfhi(gv[n].y), bflo(gv[n].z), bfhi(gv[n].z), bflo(gv[n].w), bfhi(gv[n].w)};
        float ss = 0.f;
#pragma unroll
        for (int i = 0; i < 8; ++i) ss += of[i] * of[i];
        ss = wave_sum(ss);
        const float r = 1.0f / sqrtf(ss * (1.0f / DV) + EPS);
#pragma unroll
        for (int i = 0; i < 8; ++i) { const float s = gf[i] * __builtin_amdgcn_rcpf(1.0f + __builtin_amdgcn_exp2f(gf[i] * -1.4426950408889634f)); of[i] = s * of[i] * r; }
        v4u w; w.x = pk2(of[0], of[1]); w.y = pk2(of[2], of[3]); w.z = pk2(of[4], of[5]); w.w = pk2(of[6], of[7]);
        *((v4u*)og[n] + lane) = w; }
}
template <int NB>
__device__ __forceinline__ void comb_items(const bf16* const (&ao)[NB], bf16* const (&oa)[NB], float lam, int lane) {
    const int vhalf = lane >> 5, e = (lane & 31) * 4;
    v2u a[NB], b[NB];
#pragma unroll
    for (int n = 0; n < NB; ++n) { a[n] = *(const v2u*)(ao[n] + vhalf * 128 + e); b[n] = *(const v2u*)(ao[n] + (2 + vhalf) * 128 + e); }
#pragma unroll
    for (int n = 0; n < NB; ++n) {
        float v[4] = {bflo(a[n].x) - lam * bflo(b[n].x), bfhi(a[n].x) - lam * bfhi(b[n].x), bflo(a[n].y) - lam * bflo(b[n].y), bfhi(a[n].y) - lam * bfhi(b[n].y)};
        float ss = (v[0] * v[0] + v[1] * v[1]) + (v[2] * v[2] + v[3] * v[3]);
        ss = wave_sum(ss);
        const float r = 1.0f / sqrtf(ss * (1.0f / 256.0f) + EPS);
        v2u w; w.x = pk2(v[0] * r, v[1] * r); w.y = pk2(v[2] * r, v[3] * r);
        *(v2u*)(oa[n] + vhalf * 128 + e) = w; }
}

namespace ret {
constexpr int QK_STRIDE = 528;
constexpr int Q_OFF = 0, K_OFF = 64 * QK_STRIDE, V_OFF = 2 * 64 * QK_STRIDE, VD_OFF = V_OFF + 8192, S_OFF = VD_OFF + 8192;
static_assert(S_OFF + 65536 <= LDS_MAIN, "retention LDS map");
__device__ __forceinline__ int v_off(int row, int ch) { return row * 128 + ((ch ^ ((row & 2) << 1)) << 4); }
typedef short v4i16_t __attribute__((ext_vector_type(4)));
__device__ __forceinline__ s16x4 vtr(const LAS unsigned char* p) { return __builtin_bit_cast(s16x4, __builtin_amdgcn_ds_read_tr16_b64_v4i16((LAS v4i16_t*)p)); }
__device__ __forceinline__ int vbase(int lane, int nq) {
    const int i = lane & 15, q = i >> 2, p = i & 3, h = lane >> 5, cg = (lane >> 4) & 1, fq = (q >> 1) & 1;
    return (8 * h + q) * 128 + ((4 * (nq ^ fq) + 2 * cg + (p >> 1)) << 4) + (p & 1) * 8;
}
__device__ __forceinline__ bf16x8 tr_frag_v(const LAS unsigned char* img, int vb, int kb) {
    const s16x4 lo = vtr(img + vb + kb * 128), hi = vtr(img + vb + kb * 128 + 512);
    return (bf16x8){lo[0], lo[1], lo[2], lo[3], hi[0], hi[1], hi[2], hi[3]};
}
__device__ __forceinline__ int kbase(int lane) {
    const int i = lane & 15, q = i >> 2, p = i & 3, h = lane >> 5, cg = (lane >> 4) & 1;
    return (8 * h + q) * QK_STRIDE + (16 * cg + 4 * p) * 2;
}
__device__ __forceinline__ bf16x8 tr_frag_k(const LAS unsigned char* img, int kbs, int kb, int nb) {
    const s16x4 lo = vtr(img + kbs + kb * QK_STRIDE + nb * 2), hi = vtr(img + kbs + (kb + 4) * QK_STRIDE + nb * 2);
    return (bf16x8){lo[0], lo[1], lo[2], lo[3], hi[0], hi[1], hi[2], hi[3]};
}
__device__ __forceinline__ int rbase(int lane) { return (lane & 31) * QK_STRIDE + (lane >> 5) * 16; }
__device__ __forceinline__ bf16x8 row_frag(const LAS unsigned char* img, int rbs, int rb, int kb) {
    return *(const LAS bf16x8*)(img + rbs + rb * QK_STRIDE + kb * 2);
}

#define TRPK(lo, hi) (bf16x8){lo[0], lo[1], lo[2], lo[3], hi[0], hi[1], hi[2], hi[3]}
template <int D0> __device__ __forceinline__ void sc_load(bf16x8 (&f)[12], int qa, int ka) {
#pragma unroll
    for (int i = 0; i < 4; ++i) { }
    f[0] = lds_rd128<(D0 + 0) * 32>(qa); f[1] = lds_rd128<(D0 + 0) * 32>(ka); f[2] = lds_rd128<32 * QK_STRIDE + (D0 + 0) * 32>(ka);
    f[3] = lds_rd128<(D0 + 1) * 32>(qa); f[4] = lds_rd128<(D0 + 1) * 32>(ka); f[5] = lds_rd128<32 * QK_STRIDE + (D0 + 1) * 32>(ka);
    f[6] = lds_rd128<(D0 + 2) * 32>(qa); f[7] = lds_rd128<(D0 + 2) * 32>(ka); f[8] = lds_rd128<32 * QK_STRIDE + (D0 + 2) * 32>(ka);
    f[9] = lds_rd128<(D0 + 3) * 32>(qa); f[10] = lds_rd128<(D0 + 3) * 32>(ka); f[11] = lds_rd128<32 * QK_STRIDE + (D0 + 3) * 32>(ka);
}
__device__ __forceinline__ void sc_mma(f32x16& p0, f32x16& p1, const bf16x8 (&f)[12]) {
#pragma unroll
    for (int i = 0; i < 4; ++i) { p0 = __builtin_amdgcn_mfma_f32_32x32x16_bf16(f[3 * i + 1], f[3 * i], p0, 0, 0, 0); p1 = __builtin_amdgcn_mfma_f32_32x32x16_bf16(f[3 * i + 2], f[3 * i], p1, 0, 0, 0); }
}
template <int D0> __device__ __forceinline__ void qs_load(bf16x8 (&q)[4], s16x4 (&s)[8], int qa, int sa, int sb) {
    q[0] = lds_rd128<(D0 + 0) * 32>(qa); s[0] = lds_tr64<(D0 + 0) * 16 * 128>(sa); s[1] = lds_tr64<(D0 + 0) * 16 * 128>(sb);
    q[1] = lds_rd128<(D0 + 1) * 32>(qa); s[2] = lds_tr64<(D0 + 1) * 16 * 128>(sa); s[3] = lds_tr64<(D0 + 1) * 16 * 128>(sb);
    q[2] = lds_rd128<(D0 + 2) * 32>(qa); s[4] = lds_tr64<(D0 + 2) * 16 * 128>(sa); s[5] = lds_tr64<(D0 + 2) * 16 * 128>(sb);
    q[3] = lds_rd128<(D0 + 3) * 32>(qa); s[6] = lds_tr64<(D0 + 3) * 16 * 128>(sa); s[7] = lds_tr64<(D0 + 3) * 16 * 128>(sb);
}
__device__ __forceinline__ void qs_mma(f32x16& o2, const bf16x8 (&q)[4], const s16x4 (&s)[8]) {
#pragma unroll
    for (int i = 0; i < 4; ++i) o2 = __builtin_amdgcn_mfma_f32_32x32x16_bf16(q[i], TRPK(s[2 * i], s[2 * i + 1]), o2, 0, 0, 0);
}
template <int KS> __device__ __forceinline__ void st_load(s16x4 (&f)[8], int va0, int va1, int ka) {
    f[0] = lds_tr64<KS * 16 * 128>(va0); f[1] = lds_tr64<KS * 16 * 128 + 512>(va0); f[2] = lds_tr64<KS * 16 * 128>(va1); f[3] = lds_tr64<KS * 16 * 128 + 512>(va1);
    f[4] = lds_tr64<KS * 16 * QK_STRIDE>(ka); f[5] = lds_tr64<(KS * 16 + 4) * QK_STRIDE>(ka); f[6] = lds_tr64<KS * 16 * QK_STRIDE + 64>(ka); f[7] = lds_tr64<(KS * 16 + 4) * QK_STRIDE + 64>(ka);
}
__device__ __forceinline__ void st_mma(f32x16 (&acc)[2][2], const s16x4 (&f)[8]) {
    const bf16x8 a0 = TRPK(f[0], f[1]), a1 = TRPK(f[2], f[3]), b0 = TRPK(f[4], f[5]), b1 = TRPK(f[6], f[7]);
    acc[0][0] = __builtin_amdgcn_mfma_f32_32x32x16_bf16(a0, b0, acc[0][0], 0, 0, 0); acc[0][1] = __builtin_amdgcn_mfma_f32_32x32x16_bf16(a0, b1, acc[0][1], 0, 0, 0);
    acc[1][0] = __builtin_amdgcn_mfma_f32_32x32x16_bf16(a1, b0, acc[1][0], 0, 0, 0); acc[1][1] = __builtin_amdgcn_mfma_f32_32x32x16_bf16(a1, b1, acc[1][1], 0, 0, 0);
}

struct Seq {
    const bf16* proj;
    bf16* oret;
    const float* S0;
    float* Sout;
    int nchunks, pad;
    const float* cvt_src;
    bf16* cvt_dst; int cvt_chunk0;
};

__device__ __forceinline__ void unit(const Seq& sq, int h, int s, float l2g, LAS unsigned char* lds) {
    int tid = threadIdx.x; asm volatile("" : "+v"(tid));
    const int wid = __builtin_amdgcn_readfirstlane(tid >> 6), lane = tid & 63, r32 = lane & 31, hi = lane >> 5;
    LAS unsigned char* Qi = lds + Q_OFF; LAS unsigned char* Ki = lds + K_OFF; LAS unsigned char* Vi = lds + V_OFF; LAS unsigned char* Vdi = lds + VD_OFF;
    const bf16* qg = sq.proj + h * 256; const bf16* kg = sq.proj + 2048 + h * 256; const bf16* vg = sq.proj + 4096 + h * 512 + s * 64;
    const int srow = tid >> 3, sch = tid & 7;
    const float vdec = __builtin_amdgcn_exp2f(l2g * 63.0f);
    v4u sq_[4], sk_[4], sv_;
#define RET_SLOAD(c) do { const int t_ = (c) * 64 + srow - sq.pad; if (t_ >= 0) { const size_t ro_ = (size_t)t_ * 12288; \
        _Pragma("unroll") for (int i_ = 0; i_ < 4; ++i_) { sq_[i_] = *(const v4u*)(qg + ro_ + (sch + 8 * i_) * 8); sk_[i_] = *(const v4u*)(kg + ro_ + (sch + 8 * i_) * 8); } \
        sv_ = *(const v4u*)(vg + ro_ + sch * 8); } else { _Pragma("unroll") for (int i_ = 0; i_ < 4; ++i_) { sq_[i_] = (v4u){0u, 0u, 0u, 0u}; sk_[i_] = (v4u){0u, 0u, 0u, 0u}; } sv_ = (v4u){0u, 0u, 0u, 0u}; } } while (0)
#define RET_SWRITE() do { _Pragma("unroll") for (int i_ = 0; i_ < 4; ++i_) { *(LAS v4u*)(Qi + srow * QK_STRIDE + (sch + 8 * i_) * 16) = sq_[i_]; *(LAS v4u*)(Ki + srow * QK_STRIDE + (sch + 8 * i_) * 16) = sk_[i_]; } \
        *(LAS v4u*)(Vi + v_off(srow, sch)) = sv_; v4u d_; d_.x = pk2(bflo(sv_.x) * vdec, bfhi(sv_.x) * vdec); d_.y = pk2(bflo(sv_.y) * vdec, bfhi(sv_.y) * vdec); \
        d_.z = pk2(bflo(sv_.z) * vdec, bfhi(sv_.z) * vdec); d_.w = pk2(bflo(sv_.w) * vdec, bfhi(sv_.w) * vdec); *(LAS v4u*)(Vdi + v_off(srow, sch)) = d_; } while (0)

    const bool statew = wid >= 4; const int x = wid & 3;
    const int ti = x & 1, tn = x >> 1;
    const int rbs = rbase(lane), kbs = kbase(lane) + (statew ? 128 * x : 0), vb0 = vbase(lane, 0), vb1 = vbase(lane, 1), vbt = tn ? vb1 : vb0;
    const int qaddr = (int)(unsigned)(uintptr_t)Qi + rbs + ti * 32 * QK_STRIDE, kaddr = (int)(unsigned)(uintptr_t)Ki + rbs, vaddr = (int)(unsigned)(uintptr_t)Vi + vbt;
    const int vdaddr0 = (int)(unsigned)(uintptr_t)Vdi + vb0, vdaddr1 = (int)(unsigned)(uintptr_t)Vdi + vb1, ktaddr = (int)(unsigned)(uintptr_t)Ki + kbs;
#define RET_FLO4 (((r32 >> 2) & 3) << 4)
    const int fq2 = (r32 >> 1) & 1, sb0 = (64 * x + r32) * 128 + ((4 * (0 ^ fq2)) << 4) + hi * 8, sb1 = (64 * x + r32) * 128 + ((4 * (1 ^ fq2)) << 4) + hi * 8;
    f32x16 acc[2][2];
#pragma unroll
    for (int rb = 0; rb < 2; ++rb)
#pragma unroll
        for (int cb = 0; cb < 2; ++cb) acc[rb][cb] = (f32x16){};
    __syncthreads();
    if (statew) {
        if (sq.S0) {
            const float pre = __builtin_amdgcn_exp2f(-l2g * (float)sq.pad);
#pragma unroll
            for (int rb = 0; rb < 2; ++rb)
#pragma unroll
                for (int cb = 0; cb < 2; ++cb) { const float* sp = sq.S0 + (size_t)(64 * x + 32 * cb + r32) * 512 + s * 64 + 32 * rb + 4 * hi;
#pragma unroll
                    for (int g = 0; g < 4; ++g) { const f32x4 v = *(const f32x4*)(sp + 8 * g); acc[rb][cb][4 * g + 0] = v.x * pre; acc[rb][cb][4 * g + 1] = v.y * pre; acc[rb][cb][4 * g + 2] = v.z * pre; acc[rb][cb][4 * g + 3] = v.w * pre; } }
        }
#pragma unroll
        for (int rb = 0; rb < 2; ++rb)
#pragma unroll
            for (int cb = 0; cb < 2; ++cb) {
#pragma unroll
                for (int g = 0; g < 4; ++g) { v2u w; w.x = pk2(acc[rb][cb][4 * g], acc[rb][cb][4 * g + 1]); w.y = pk2(acc[rb][cb][4 * g + 2], acc[rb][cb][4 * g + 3]);
                    *(LAS v2u*)(lds + S_OFF + (rb ? sb1 : sb0) + cb * 4096 + ((g * 16) ^ RET_FLO4)) = w; } }
    }
    RET_SLOAD(0); RET_SWRITE();
    __syncthreads();
    const float cdec = __builtin_amdgcn_exp2f(l2g * 64.0f), gam = __builtin_amdgcn_exp2f(l2g);
    for (int c = 0; c < sq.nchunks; ++c) {
        const LAS unsigned char* Scur = lds + S_OFF + (c & 1) * 32768; LAS unsigned char* Snxt = lds + S_OFF + ((c + 1) & 1) * 32768;
        const bool more = (c + 1 < sq.nchunks);
        if (more) RET_SLOAD(c + 1);
        if (!statew) {
            f32x16 p0 = (f32x16){}, p1 = (f32x16){};
            { bf16x8 fa[12], fb[12];
              sc_load<0>(fa, qaddr, kaddr); LDS_WAIT_SB(0);
              sc_load<4>(fb, qaddr, kaddr); sc_mma(p0, p1, fa); LDS_WAIT_SB(0);
              sc_load<8>(fa, qaddr, kaddr); sc_mma(p0, p1, fb); LDS_WAIT_SB(0);
              sc_load<12>(fb, qaddr, kaddr); sc_mma(p0, p1, fa); LDS_WAIT_SB(0);
              sc_mma(p0, p1, fb); }
            const int ipos = 32 * ti + r32;
#pragma unroll
            for (int r = 0; r < 16; ++r) { const int j0 = crow(r, hi), j1 = 32 + j0;
                p0[r] = (ipos >= j0) ? p0[r] : 0.f;
                p1[r] = (ipos >= j1) ? p1[r] : 0.f; }
            bf16x8 pa0, pa1, pa2, pa3;
#define RET_PK4(P, BASE, OUT) do { unsigned a0 = pk2(P[BASE + 0], P[BASE + 1]), a1 = pk2(P[BASE + 2], P[BASE + 3]); \
    unsigned b0 = pk2(P[BASE + 4], P[BASE + 5]), b1 = pk2(P[BASE + 6], P[BASE + 7]); \
    auto r0 = __builtin_amdgcn_permlane32_swap(a0, b0, false, false); auto r1 = __builtin_amdgcn_permlane32_swap(a1, b1, false, false); \
    v4u w = {r0[0], r1[0], r0[1], r1[1]}; OUT = __builtin_bit_cast(bf16x8, w); } while (0)
            RET_PK4(p0, 0, pa0); RET_PK4(p0, 8, pa1); RET_PK4(p1, 0, pa2); RET_PK4(p1, 8, pa3);
#undef RET_PK4
            f32x16 o2 = (f32x16){};
            const int saddr = (int)(unsigned)(uintptr_t)Scur + (vbt ^ (hi << 5)), saddr1 = (saddr ^ 16) + 512;
            { bf16x8 qa_[4], qb_[4]; s16x4 sa_[8], sb_[8];
              qs_load<0>(qa_, sa_, qaddr, saddr, saddr1); LDS_WAIT_SB(0);
              qs_load<4>(qb_, sb_, qaddr, saddr, saddr1); qs_mma(o2, qa_, sa_); LDS_WAIT_SB(0);
              qs_load<8>(qa_, sa_, qaddr, saddr, saddr1); qs_mma(o2, qb_, sb_); LDS_WAIT_SB(0);
              qs_load<12>(qb_, sb_, qaddr, saddr, saddr1); qs_mma(o2, qa_, sa_); LDS_WAIT_SB(0);
              s16x4 v_[8];
              v_[0] = lds_tr64<0>(vaddr); v_[1] = lds_tr64<512>(vaddr); v_[2] = lds_tr64<16 * 128>(vaddr); v_[3] = lds_tr64<16 * 128 + 512>(vaddr);
              v_[4] = lds_tr64<32 * 128>(vaddr); v_[5] = lds_tr64<32 * 128 + 512>(vaddr); v_[6] = lds_tr64<48 * 128>(vaddr); v_[7] = lds_tr64<48 * 128 + 512>(vaddr);
              qs_mma(o2, qb_, sb_); LDS_WAIT_SB(0);
              f32x16 o1_;
#pragma unroll
              for (int r = 0; r < 16; ++r) o1_[r] = o2[r] * gam;
              o1_ = __builtin_amdgcn_mfma_f32_32x32x16_bf16(pa0, TRPK(v_[0], v_[1]), o1_, 0, 0, 0);
              o1_ = __builtin_amdgcn_mfma_f32_32x32x16_bf16(pa1, TRPK(v_[2], v_[3]), o1_, 0, 0, 0);
              o1_ = __builtin_amdgcn_mfma_f32_32x32x16_bf16(pa2, TRPK(v_[4], v_[5]), o1_, 0, 0, 0);
              o1_ = __builtin_amdgcn_mfma_f32_32x32x16_bf16(pa3, TRPK(v_[6], v_[7]), o1_, 0, 0, 0);
              o2 = o1_; }
            const f32x16 o1 = o2;
            bf16* ob = sq.oret + h * 512 + s * 64 + 32 * tn + r32;
            if (c * 64 + 32 * ti >= sq.pad) {
                bf16* ob2 = ob + (size_t)(c * 64 + 32 * ti - sq.pad) * 4096;
#pragma unroll
                for (int r = 0; r < 16; ++r) ob2[(size_t)crow(r, hi) * 4096] = (bf16)(pk2(o1[r], 0.f) & 0xffffu); }
        } else {
            f32x4 cv_[4]; int cchunk_ = 0;
            if (sq.cvt_src) { cchunk_ = sq.cvt_chunk0 + c * 4 + x; const f32x4* sp_ = (const f32x4*)(sq.cvt_src + (size_t)cchunk_ * 1024) + lane * 4;
#pragma unroll
                for (int i_ = 0; i_ < 4; ++i_) cv_[i_] = sp_[i_]; }
#pragma unroll
            for (int rb = 0; rb < 2; ++rb)
#pragma unroll
                for (int cb = 0; cb < 2; ++cb) acc[rb][cb] = acc[rb][cb] * cdec;
            { s16x4 fa[8], fb[8];
              st_load<0>(fa, vdaddr0, vdaddr1, ktaddr); LDS_WAIT_SB(0);
              st_load<1>(fb, vdaddr0, vdaddr1, ktaddr); st_mma(acc, fa); LDS_WAIT_SB(0);
              st_load<2>(fa, vdaddr0, vdaddr1, ktaddr); st_mma(acc, fb); LDS_WAIT_SB(0);
              st_load<3>(fb, vdaddr0, vdaddr1, ktaddr); st_mma(acc, fa); LDS_WAIT_SB(0);
              st_mma(acc, fb); }
            if (more) {
#pragma unroll
                for (int rb = 0; rb < 2; ++rb)
#pragma unroll
                    for (int cb = 0; cb < 2; ++cb) {
#pragma unroll
                        for (int g = 0; g < 4; ++g) { v2u w; w.x = pk2(acc[rb][cb][4 * g], acc[rb][cb][4 * g + 1]); w.y = pk2(acc[rb][cb][4 * g + 2], acc[rb][cb][4 * g + 3]);
                            *(LAS v2u*)(Snxt + (rb ? sb1 : sb0) + cb * 4096 + ((g * 16) ^ RET_FLO4)) = w; } }
            }
            if (sq.cvt_src) { const int e0_ = cchunk_ * 1024 + lane * 16, row_ = e0_ >> 11, col_ = e0_ & 2047;
                bf16* dp_ = sq.cvt_dst + ((size_t)(row_ >> 10) * SKV_S + (row_ & 1023)) * 2048 + col_;
                v4u w0_, w1_; w0_.x = pk2(cv_[0].x, cv_[0].y); w0_.y = pk2(cv_[0].z, cv_[0].w); w0_.z = pk2(cv_[1].x, cv_[1].y); w0_.w = pk2(cv_[1].z, cv_[1].w);
                w1_.x = pk2(cv_[2].x, cv_[2].y); w1_.y = pk2(cv_[2].z, cv_[2].w); w1_.z = pk2(cv_[3].x, cv_[3].y); w1_.w = pk2(cv_[3].z, cv_[3].w);
                *(v4u*)dp_ = w0_; *(v4u*)(dp_ + 8) = w1_; }
        }
        __syncthreads();
        if (more) { RET_SWRITE(); }
        __syncthreads();
    }
    if (statew) {
#pragma unroll
        for (int rb = 0; rb < 2; ++rb)
#pragma unroll
            for (int cb = 0; cb < 2; ++cb) { float* sp = sq.Sout + (size_t)(64 * x + 32 * cb + r32) * 512 + s * 64 + 32 * rb + 4 * hi;
#pragma unroll
                for (int g = 0; g < 4; ++g) *(f32x4*)(sp + 8 * g) = (f32x4){acc[rb][cb][4 * g], acc[rb][cb][4 * g + 1], acc[rb][cb][4 * g + 2], acc[rb][cb][4 * g + 3]}; }
    }
#undef RET_SLOAD
#undef RET_FLO4
#undef RET_SWRITE
}
}

namespace a16 {
constexpr int KST = 288, VST = 544;
constexpr int SHM_K = 64 * KST, SHM_V = 64 * VST, SHM_T = SHM_K + SHM_V, SHM_SCR = 3 * SHM_T, SHM_ATT = SHM_SCR + 8 * 256;
static_assert(SHM_ATT <= LDS_MAIN, "att16 LDS map");
constexpr float SCALE = 0.088388347648318440f, THR = 8.f;
constexpr int LDQ = 2048, LDK = 2048, LDO = 4096;
typedef float f32x2 __attribute__((ext_vector_type(2)));
struct Sc { f32x4 k[4]; };
__device__ __forceinline__ s16x4 vtr(const LAS unsigned char* p) { return __builtin_bit_cast(s16x4, __builtin_amdgcn_ds_read_tr16_b64_v4i16((LAS ret::v4i16_t*)p)); }

template <int OFF> __device__ __forceinline__ bf16x8 rd128(int a) { return lds_rd128<OFF>(a); }
template <int OFF> __device__ __forceinline__ s16x4 tr64(int a) { return lds_tr64<OFF>(a); }
#define A16_WAIT(n) do { asm volatile("s_waitcnt lgkmcnt(" #n ")" ::: "memory"); __builtin_amdgcn_sched_barrier(0); } while (0)
template <int KB, int S2, int KSTR = KST> __device__ __forceinline__ void kload(bf16x8 (&f)[2], int ka) { f[0] = rd128<KB * 16 * KSTR + S2 * 64>(ka); f[1] = rd128<KB * 16 * KSTR + S2 * 64 + 64>(ka); }
template <bool LEAN, int KSTR = KST> __device__ __forceinline__ void qkt(Sc& sc, int ka, const bf16x8 (&qf)[4]) {
    if constexpr (LEAN) {
        bf16x8 fa[2], fb[2];
#pragma unroll
        for (int kb = 0; kb < 4; ++kb) sc.k[kb] = (f32x4){0.f, 0.f, 0.f, 0.f};
#define A16_KMMA(KB, S2, F) do { sc.k[KB] = __builtin_amdgcn_mfma_f32_16x16x32_bf16(F[0], qf[S2], sc.k[KB], 0, 0, 0); sc.k[KB] = __builtin_amdgcn_mfma_f32_16x16x32_bf16(F[1], qf[S2 + 1], sc.k[KB], 0, 0, 0); } while (0)
        kload<0, 0, KSTR>(fa, ka); kload<0, 2, KSTR>(fb, ka);
        A16_WAIT(2); A16_KMMA(0, 0, fa); kload<1, 0, KSTR>(fa, ka);
        A16_WAIT(2); A16_KMMA(0, 2, fb); kload<1, 2, KSTR>(fb, ka);
        A16_WAIT(2); A16_KMMA(1, 0, fa); kload<2, 0, KSTR>(fa, ka);
        A16_WAIT(2); A16_KMMA(1, 2, fb); kload<2, 2, KSTR>(fb, ka);
        A16_WAIT(2); A16_KMMA(2, 0, fa); kload<3, 0, KSTR>(fa, ka);
        A16_WAIT(2); A16_KMMA(2, 2, fb); kload<3, 2, KSTR>(fb, ka);
        A16_WAIT(2); A16_KMMA(3, 0, fa);
        A16_WAIT(0); A16_KMMA(3, 2, fb);
#undef A16_KMMA
        return;
    }
    bf16x8 fa[4], fb[4];
#define A16_KL4(KB, F) do { F[0] = rd128<KB * 16 * KSTR>(ka); F[1] = rd128<KB * 16 * KSTR + 64>(ka); F[2] = rd128<KB * 16 * KSTR + 128>(ka); F[3] = rd128<KB * 16 * KSTR + 192>(ka); } while (0)
#define A16_KM4(KB, F) do { f32x4 a_ = (f32x4){0.f, 0.f, 0.f, 0.f}; _Pragma("unroll") for (int s = 0; s < 4; ++s) a_ = __builtin_amdgcn_mfma_f32_16x16x32_bf16(F[s], qf[s], a_, 0, 0, 0); sc.k[KB] = a_; } while (0)
    A16_KL4(0, fa); A16_KL4(1, fb);
    A16_WAIT(4); A16_KM4(0, fa); A16_KL4(2, fa);
    A16_WAIT(4); A16_KM4(1, fb); A16_KL4(3, fb);
    A16_WAIT(4); A16_KM4(2, fa);
    A16_WAIT(0); A16_KM4(3, fb);
#undef A16_KL4
#undef A16_KM4
}
template <bool FAST>
__device__ __forceinline__ bool softmax_tile(Sc& sc, float& m_reg, float& l_reg, float& alpha, float qrel, float nb, int kl, int g, bool past) {
    constexpr float C = SCALE * 1.4426950408889634f;
    if (FAST && past) {
        const f32x2 n2 = {nb, nb};
#pragma unroll
        for (int kb = 0; kb < 4; ++kb) { const float b = qrel - 16.f * kb; f32x2 e01 = {b, b - 1.f}, e23 = e01 - 2.f;
            f32x2 a = {sc.k[kb][0], sc.k[kb][1]}, c = {sc.k[kb][2], sc.k[kb][3]}; a = __builtin_elementwise_fma(e01, n2, a); c = __builtin_elementwise_fma(e23, n2, c);
            sc.k[kb] = (f32x4){a.x, a.y, c.x, c.y}; }
    } else {
#pragma unroll
        for (int kb = 0; kb < 4; ++kb) { const float b = qrel - 16.f * kb, e1 = b - 1.f, e2 = b - 2.f, e3 = e1 - 2.f;
            sc.k[kb][0] = fmaf(fabsf(b), nb, sc.k[kb][0]); sc.k[kb][1] = fmaf(fabsf(e1), nb, sc.k[kb][1]); sc.k[kb][2] = fmaf(fabsf(e2), nb, sc.k[kb][2]); sc.k[kb][3] = fmaf(fabsf(e3), nb, sc.k[kb][3]); }
        if (kl < 64) {
#pragma unroll
            for (int kb = 0; kb < 4; ++kb)
#pragma unroll
                for (int r = 0; r < 4; ++r) if (16 * kb + 4 * g + r >= kl) sc.k[kb][r] = -3.0e38f;
        }
    }
    float pmax = fmaxf(fmaxf(sc.k[0][0], sc.k[0][1]), fmaxf(sc.k[0][2], sc.k[0][3]));
#pragma unroll
    for (int kb = 1; kb < 4; ++kb) pmax = fmaxf(pmax, fmaxf(fmaxf(sc.k[kb][0], sc.k[kb][1]), fmaxf(sc.k[kb][2], sc.k[kb][3])));
    { auto rr = __builtin_amdgcn_permlane16_swap(__float_as_uint(pmax), __float_as_uint(pmax), false, false); pmax = fmaxf(__uint_as_float(rr[0]), __uint_as_float(rr[1])); }
    { auto rr = __builtin_amdgcn_permlane32_swap(__float_as_uint(pmax), __float_as_uint(pmax), false, false); pmax = fmaxf(__uint_as_float(rr[0]), __uint_as_float(rr[1])); }
    if (__all(pmax - m_reg < -160.f / C)) { alpha = 1.f; return true; }
    float mn;
    if (__builtin_expect(__all(pmax - m_reg <= THR / SCALE), 1)) { mn = m_reg; alpha = 1.f; }
    else { mn = fmaxf(m_reg, pmax); alpha = __builtin_amdgcn_exp2f((m_reg - mn) * C); m_reg = mn; }
    const float mnC = -mn * C; float ps = 0.f;
#pragma unroll
    for (int kb = 0; kb < 4; ++kb)
#pragma unroll
        for (int r = 0; r < 4; ++r) { const float p = __builtin_amdgcn_exp2f(fmaf(sc.k[kb][r], C, mnC)); sc.k[kb][r] = p; ps += p; }
    { auto rr = __builtin_amdgcn_permlane16_swap(__float_as_uint(ps), __float_as_uint(ps), false, false); ps = __uint_as_float(rr[0]) + __uint_as_float(rr[1]); }
    { auto rr = __builtin_amdgcn_permlane32_swap(__float_as_uint(ps), __float_as_uint(ps), false, false); ps = __uint_as_float(rr[0]) + __uint_as_float(rr[1]); }
    l_reg = l_reg * alpha + ps;
    return false;
}
template <int CB> __device__ __forceinline__ void vload(s16x4 (&f)[4], int va) {
    f[0] = tr64<CB * 32>(va); f[1] = tr64<16 * VST + CB * 32>(va); f[2] = tr64<32 * VST + CB * 32>(va); f[3] = tr64<48 * VST + CB * 32>(va);
}
template <int CB> __device__ __forceinline__ void vmma(f32x4 (&o)[16], const s16x4 (&f)[4], const bf16x8 (&pa)[2]) {
#pragma unroll
    for (int s = 0; s < 2; ++s) { const s16x4 lo = f[2 * s], hi = f[2 * s + 1];
        o[CB] = __builtin_amdgcn_mfma_f32_16x16x32_bf16(pa[s], (bf16x8){lo[0], lo[1], lo[2], lo[3], hi[0], hi[1], hi[2], hi[3]}, o[CB], 0, 0, 0); }
}
template <bool LEAN> __device__ __forceinline__ void pv(f32x4 (&o)[16], const Sc& sc, int va) {
    bf16x8 pa[2];
#pragma unroll
    for (int s = 0; s < 2; ++s) { v4u w; w.x = pk2(sc.k[2 * s][0], sc.k[2 * s][1]); w.y = pk2(sc.k[2 * s][2], sc.k[2 * s][3]); w.z = pk2(sc.k[2 * s + 1][0], sc.k[2 * s + 1][1]); w.w = pk2(sc.k[2 * s + 1][2], sc.k[2 * s + 1][3]);
        pa[s] = __builtin_bit_cast(bf16x8, w); }
    if constexpr (LEAN) {
        s16x4 fa[4], fb[4];
        vload<0>(fa, va); vload<1>(fb, va);
#define A16_PVL(CB, F, NEXT) do { A16_WAIT(4); vmma<CB>(o, F, pa); vload<NEXT>(F, va); } while (0)
        A16_PVL(0, fa, 2); A16_PVL(1, fb, 3); A16_PVL(2, fa, 4); A16_PVL(3, fb, 5); A16_PVL(4, fa, 6); A16_PVL(5, fb, 7); A16_PVL(6, fa, 8); A16_PVL(7, fb, 9);
        A16_PVL(8, fa, 10); A16_PVL(9, fb, 11); A16_PVL(10, fa, 12); A16_PVL(11, fb, 13); A16_PVL(12, fa, 14); A16_PVL(13, fb, 15);
        A16_WAIT(4); vmma<14>(o, fa, pa);
        A16_WAIT(0); vmma<15>(o, fb, pa);
#undef A16_PVL
        return;
    }
    s16x4 fa[4], fb[4], fc[4], fd[4];
    vload<0>(fa, va); vload<1>(fb, va); vload<2>(fc, va); vload<3>(fd, va);
#define A16_PV2(CB, F, G, NEXT) do { A16_WAIT(8); vmma<CB>(o, F, pa); vmma<CB + 1>(o, G, pa); vload<NEXT>(F, va); vload<NEXT + 1>(G, va); } while (0)
    A16_PV2(0, fa, fb, 4); A16_PV2(2, fc, fd, 6); A16_PV2(4, fa, fb, 8); A16_PV2(6, fc, fd, 10); A16_PV2(8, fa, fb, 12); A16_PV2(10, fc, fd, 14);
    A16_WAIT(8); vmma<12>(o, fa, pa); vmma<13>(o, fb, pa);
    A16_WAIT(0); vmma<14>(o, fc, pa); vmma<15>(o, fd, pa);
#undef A16_PV2
}
template <bool GUARD>
__device__ __forceinline__ void attn_core(f32x4 (&o)[16], const bf16* __restrict__ Qb, const bf16* __restrict__ Kh, const bf16* __restrict__ Vh,
                                          int NT, int qpos0, int klim, bool act, float nb, LAS unsigned char* lds, const unsigned* __restrict__ kmax4) {
    int tid = threadIdx.x; asm volatile("" : "+v"(tid));
    const int wid = __builtin_amdgcn_readfirstlane(tid >> 6), lane = tid & 63, q16 = lane & 15, g = lane >> 4;
    LAS float* scr = (LAS float*)(lds + SHM_SCR + wid * 256);
    const int kb_ = q16 * KST + g * 16;
    const int vb_ = (4 * g + (q16 >> 2)) * VST + (q16 & 3) * 8;
    const int srow = tid >> 3, sch = tid & 7;
    const unsigned soff = (unsigned)(srow * LDK * 2 + sch * 16);
    const int kwr = srow * KST + sch * 16, vwr = srow * VST + sch * 16;
    const int kaddr0 = (int)(unsigned)(uintptr_t)lds + kb_, vaddr0 = (int)(unsigned)(uintptr_t)lds + SHM_K + vb_;
    float m_reg = -1e30f, l_reg = 0.f;
#pragma unroll
    for (int cb = 0; cb < 16; ++cb) o[cb] = (f32x4){0.f, 0.f, 0.f, 0.f};
    bf16x8 qf[4];
#define CMP(...) do { if (!GUARD || act) { __VA_ARGS__ } } while (0)
#pragma unroll
    for (int s = 0; s < 4; ++s) qf[s] = (bf16x8){0, 0, 0, 0, 0, 0, 0, 0};
    CMP( const bf16* Qw = Qb + (size_t)(wid * 16 + q16) * LDQ + g * 8;
         _Pragma("unroll") for (int s = 0; s < 4; ++s) qf[s] = *(const bf16x8*)(Qw + s * 32); );
    const float qposf = (float)(qpos0 + wid * 16 + q16 - 4 * g); const int qmin = qpos0 + wid * 16;
    float qn2 = 0.f;
    if constexpr (!GUARD) {
#pragma unroll
        for (int s = 0; s < 4; ++s) { const v4u w = __builtin_bit_cast(v4u, qf[s]);
            qn2 += (bflo(w.x) * bflo(w.x) + bfhi(w.x) * bfhi(w.x)) + (bflo(w.y) * bflo(w.y) + bfhi(w.y) * bfhi(w.y)) + (bflo(w.z) * bflo(w.z) + bfhi(w.z) * bfhi(w.z)) + (bflo(w.w) * bflo(w.w) + bfhi(w.w) * bfhi(w.w)); }
        { auto rr = __builtin_amdgcn_permlane16_swap(__float_as_uint(qn2), __float_as_uint(qn2), false, false); qn2 = __uint_as_float(rr[0]) + __uint_as_float(rr[1]); }
        { auto rr = __builtin_amdgcn_permlane32_swap(__float_as_uint(qn2), __float_as_uint(qn2), false, false); qn2 = __uint_as_float(rr[0]) + __uint_as_float(rr[1]); }
        qn2 = fmaxf(qn2, __int_as_float(__builtin_amdgcn_update_dpp(0, __float_as_int(qn2), 0xB1, 0xF, 0xF, true)));
        qn2 = fmaxf(qn2, __int_as_float(__builtin_amdgcn_update_dpp(0, __float_as_int(qn2), 0x4E, 0xF, 0xF, true)));
        qn2 = fmaxf(qn2, __int_as_float(__builtin_amdgcn_update_dpp(0, __float_as_int(qn2), 0x141, 0xF, 0xF, true)));
        qn2 = fmaxf(qn2, __int_as_float(__builtin_amdgcn_update_dpp(0, __float_as_int(qn2), 0x140, 0xF, 0xF, true)));
    }
    v4u sk_[2], sv_[4];
#define TL(i) (NT - 1 - (i))
#define SLOAD(idx) do { const char* kt_ = (const char*)Kh + (size_t)(TL(idx) * 64) * (LDK * 2) + soff; const char* vt_ = (const char*)Vh + (size_t)(TL(idx) * 64) * (LDK * 2) + soff; \
        _Pragma("unroll") for (int i_ = 0; i_ < 2; ++i_) sk_[i_] = *(const v4u*)(kt_ + i_ * 128); _Pragma("unroll") for (int i_ = 0; i_ < 4; ++i_) sv_[i_] = *(const v4u*)(vt_ + i_ * 128); } while (0)
#define SWRITE(b) do { LAS unsigned char* kt_ = lds + (b) * SHM_T; LAS unsigned char* vt_ = kt_ + SHM_K; \
        _Pragma("unroll") for (int i_ = 0; i_ < 2; ++i_) *(LAS v4u*)(kt_ + kwr + i_ * 128) = sk_[i_]; _Pragma("unroll") for (int i_ = 0; i_ < 4; ++i_) *(LAS v4u*)(vt_ + vwr + i_ * 128) = sv_[i_]; } while (0)
#define KT(b) (kaddr0 + (b) * SHM_T)
#define VT(b) (vaddr0 + (b) * SHM_T)
#define RESC(a) do { if (__any((a) < 1.f)) { if (g == 0) scr[q16] = (a); asm volatile("s_waitcnt lgkmcnt(0)" ::: "memory"); const f32x4 al_ = *(const LAS f32x4*)(scr + 4 * g); \
        _Pragma("unroll") for (int cb = 0; cb < 16; ++cb) o[cb] = o[cb] * al_; } } while (0)
#define PSM(S, AL, IDX) softmax_tile<!GUARD>(S, m_reg, l_reg, AL, qposf - (float)(TL(IDX) * 64), nb, klim - TL(IDX) * 64, g, TL(IDX) * 64 + 63 < qmin)
    Sc pA, pB; float alA = 1.f, alB = 1.f; bool dA = false, dB = false;
    constexpr bool STAG = !GUARD;
#define MIDBAR() do { if (STAG) asm volatile("s_waitcnt lgkmcnt(0)\n\ts_barrier" ::: "memory"); } while (0)
    __syncthreads();
    SLOAD(0); SWRITE(0); SLOAD(1);
    if constexpr (!GUARD) { if (lane == 0) scr[32] = qn2; }
    __syncthreads();
    int NL = NT;
    if constexpr (!GUARD) {
        float q2 = 0.f;
#pragma unroll
        for (int w = 0; w < 8; ++w) q2 = fmaxf(q2, ((const LAS float*)(lds + SHM_SCR + w * 256))[32]);
        float k2 = 0.f;
#pragma unroll
        for (int i = 0; i < 4; ++i) k2 += __uint_as_float(__hip_atomic_load(kmax4 + i, __ATOMIC_RELAXED, __HIP_MEMORY_SCOPE_AGENT));
        const float qk = sqrtf(q2 * k2) * 1.02f;
        const float dcut = (2.f * qk + THR / SCALE + 160.f / (SCALE * 1.4426950408889634f)) / -nb;
        const float nsk = floorf(((float)qpos0 - dcut) * (1.0f / 64.0f)) - 1.f;
        int nskip = nsk > 0.f ? ((int)nsk & ~1) : 0;
        nskip = __builtin_amdgcn_readfirstlane(nskip);
        NL = NT - nskip; if (NL < 2) NL = 2;
    }
    if (STAG && wid >= 4) asm volatile("s_barrier" ::: "memory");
    SWRITE(1); if (2 < NL) SLOAD(2);
    CMP( qkt<GUARD>(pA, KT(0), qf); MIDBAR(); dA = PSM(pA, alA, 0); RESC(alA); );
    int bp = 0, bc = 1, bn = 2;
    for (int j = 1; j + 1 < NL; j += 2) {
        __syncthreads();
        SWRITE(bn); SLOAD(j + 2);
        CMP( qkt<GUARD>(pB, KT(bc), qf); if (!dA) pv<GUARD>(o, pA, VT(bp)); MIDBAR(); dB = PSM(pB, alB, j); RESC(alB); );
        { const int t_ = bp; bp = bc; bc = bn; bn = t_; }
        __syncthreads();
        SWRITE(bn); if (j + 3 < NL) SLOAD(j + 3);
        CMP( qkt<GUARD>(pA, KT(bc), qf); if (!dB) pv<GUARD>(o, pB, VT(bp)); MIDBAR(); dA = PSM(pA, alA, j + 1); RESC(alA); );
        { const int t_ = bp; bp = bc; bc = bn; bn = t_; }
    }
    __syncthreads();
    CMP( qkt<GUARD>(pB, KT(bc), qf); if (!dA) pv<GUARD>(o, pA, VT(bp)); MIDBAR(); dB = PSM(pB, alB, NL - 1); RESC(alB);
         if (STAG && wid < 4) asm volatile("s_barrier" ::: "memory");
         if (!dB) pv<GUARD>(o, pB, VT(bc));
         if (g == 0) scr[q16] = l_reg; asm volatile("s_waitcnt lgkmcnt(0)" ::: "memory");
         const f32x4 lv = *(const LAS f32x4*)(scr + 4 * g);
         const f32x4 rl = (f32x4){__builtin_amdgcn_rcpf(lv.x), __builtin_amdgcn_rcpf(lv.y), __builtin_amdgcn_rcpf(lv.z), __builtin_amdgcn_rcpf(lv.w)};
         _Pragma("unroll") for (int cb = 0; cb < 16; ++cb) o[cb] = o[cb] * rl; );
#undef CMP
#undef TL
#undef SLOAD
#undef SWRITE
#undef KT
#undef VT
#undef RESC
#undef PSM
#undef MIDBAR
}
template <bool GUARD>
__device__ __forceinline__ void attn_pair(const bf16* __restrict__ Qb, const bf16* __restrict__ Kh, const bf16* __restrict__ Vh, bf16* __restrict__ OAb,
                                          int NT, int qpos0, int klim, bool act, float nb, float lam, LAS unsigned char* lds, const unsigned* __restrict__ kmax8) {
    f32x4 o[16];
    attn_core<GUARD>(o, Qb, Kh, Vh, NT, qpos0, klim, act, nb, lds, kmax8);
    unsigned p0[32];
#pragma unroll
    for (int cb = 0; cb < 16; ++cb) { p0[2 * cb] = pk2(o[cb].x, o[cb].y); p0[2 * cb + 1] = pk2(o[cb].z, o[cb].w); }
    attn_core<GUARD>(o, Qb + 128, Kh + 128, Vh, NT, qpos0, klim, act, nb, lds, kmax8 + 4);
    if (!GUARD || act) {
        int tid = threadIdx.x; asm volatile("" : "+v"(tid));
        const int wid = __builtin_amdgcn_readfirstlane(tid >> 6), lane = tid & 63, q16 = lane & 15, g = lane >> 4;
        f32x4 ss = (f32x4){0.f, 0.f, 0.f, 0.f};
#pragma unroll
        for (int cb = 0; cb < 16; ++cb) { const f32x4 a0 = (f32x4){bflo(p0[2 * cb]), bfhi(p0[2 * cb]), bflo(p0[2 * cb + 1]), bfhi(p0[2 * cb + 1])}; o[cb] = a0 - o[cb] * lam; ss = ss + o[cb] * o[cb]; }
#pragma unroll
        for (int m = 1; m < 16; m <<= 1) { ss.x += __shfl_xor(ss.x, m); ss.y += __shfl_xor(ss.y, m); ss.z += __shfl_xor(ss.z, m); ss.w += __shfl_xor(ss.w, m); }
        const f32x4 r = (f32x4){1.0f / sqrtf(ss.x * (1.0f / 256.0f) + EPS), 1.0f / sqrtf(ss.y * (1.0f / 256.0f) + EPS), 1.0f / sqrtf(ss.z * (1.0f / 256.0f) + EPS), 1.0f / sqrtf(ss.w * (1.0f / 256.0f) + EPS)};
        bf16* Ow = OAb + (size_t)(wid * 16 + 4 * g) * 2048 + q16;
#pragma unroll
        for (int cb = 0; cb < 16; ++cb) { const f32x4 v = o[cb] * r;
            Ow[cb * 16] = (bf16)(pk2(v.x, 0.f) & 0xffffu); Ow[2048 + cb * 16] = (bf16)(pk2(v.y, 0.f) & 0xffffu); Ow[2 * 2048 + cb * 16] = (bf16)(pk2(v.z, 0.f) & 0xffffu); Ow[3 * 2048 + cb * 16] = (bf16)(pk2(v.w, 0.f) & 0xffffu); }
    }
}

constexpr int KS2 = 544, SH2_K = 64 * KS2, SH2_T = SH2_K + SHM_V, SH2_SCR = 2 * SH2_T;
static_assert(SH2_SCR + 8 * 256 <= LDS_MAIN && 2 * 64 * 1024 <= SH2_SCR, "sample attention LDS map");
__device__ __forceinline__ void attn_sample2(const bf16* __restrict__ Qb, const bf16* __restrict__ Kh, const bf16* __restrict__ Vh, bf16* __restrict__ OAb,
                                             int NT, int qpos0, int klim, float nb, float lam, LAS unsigned char* lds) {
    int tid = threadIdx.x; asm volatile("" : "+v"(tid));
    const int wid = __builtin_amdgcn_readfirstlane(tid >> 6), lane = tid & 63, q16 = lane & 15, g = lane >> 4;
    const bool act = wid < 4; const int mp = (wid >> 1) & 1, r0 = (wid & 1) * 16;
    LAS float* scr = (LAS float*)(lds + SH2_SCR + wid * 256);
    const int srow = tid >> 3, sch = tid & 7;
    const unsigned soff = (unsigned)(srow * LDK * 2 + sch * 16);
    const int kwr = srow * KS2 + sch * 16, vwr = srow * VST + sch * 16;
    const int kaddr0 = (int)(unsigned)(uintptr_t)lds + q16 * KS2 + g * 16 + mp * 256;
    const int vaddr0 = (int)(unsigned)(uintptr_t)lds + SH2_K + (4 * g + (q16 >> 2)) * VST + (q16 & 3) * 8;
    float m_reg = -1e30f, l_reg = 0.f;
    f32x4 o[16];
#pragma unroll
    for (int cb = 0; cb < 16; ++cb) o[cb] = (f32x4){0.f, 0.f, 0.f, 0.f};
    bf16x8 qf[4];
#pragma unroll
    for (int s = 0; s < 4; ++s) qf[s] = (bf16x8){0, 0, 0, 0, 0, 0, 0, 0};
    if (act) { const bf16* Qw = Qb + (size_t)(r0 + q16) * LDQ + mp * 128 + g * 8;
#pragma unroll
        for (int s = 0; s < 4; ++s) qf[s] = *(const bf16x8*)(Qw + s * 32); }
    const float qposf = (float)(qpos0 + r0 + q16 - 4 * g);
    v4u sk_[4], sv_[4];
#define TL(i) (NT - 1 - (i))
#define SLOAD(idx) do { const char* kt_ = (const char*)Kh + (size_t)(TL(idx) * 64) * (LDK * 2) + soff; const char* vt_ = (const char*)Vh + (size_t)(TL(idx) * 64) * (LDK * 2) + soff; \
        _Pragma("unroll") for (int i_ = 0; i_ < 4; ++i_) { sk_[i_] = *(const v4u*)(kt_ + i_ * 128); sv_[i_] = *(const v4u*)(vt_ + i_ * 128); } } while (0)
#define SWRITE(b) do { LAS unsigned char* kt_ = lds + (b) * SH2_T; LAS unsigned char* vt_ = kt_ + SH2_K; \
        _Pragma("unroll") for (int i_ = 0; i_ < 4; ++i_) { *(LAS v4u*)(kt_ + kwr + i_ * 128) = sk_[i_]; *(LAS v4u*)(vt_ + vwr + i_ * 128) = sv_[i_]; } } while (0)
    __syncthreads();
    SLOAD(0); SWRITE(0); if (1 < NT) SLOAD(1);
    __syncthreads();
    for (int j = 0; j < NT; ++j) {
        const int cur = j & 1;
        if (j + 1 < NT) { SWRITE(1 - cur); if (j + 2 < NT) SLOAD(j + 2); }
        if (act) { Sc p; float al = 1.f;
            qkt<false, KS2>(p, kaddr0 + cur * SH2_T, qf);
            const bool dead = softmax_tile<false>(p, m_reg, l_reg, al, qposf - (float)(TL(j) * 64), nb, klim - TL(j) * 64, g, false);
            if (__any(al < 1.f)) { if (g == 0) scr[q16] = al; asm volatile("s_waitcnt lgkmcnt(0)" ::: "memory"); const f32x4 al_ = *(const LAS f32x4*)(scr + 4 * g);
#pragma unroll
                for (int cb = 0; cb < 16; ++cb) o[cb] = o[cb] * al_; }
            if (!dead) pv<false>(o, p, vaddr0 + cur * SH2_T); }
        __syncthreads();
    }
#undef TL
#undef SLOAD
#undef SWRITE
    if (act) { if (g == 0) scr[q16] = l_reg; asm volatile("s_waitcnt lgkmcnt(0)" ::: "memory");
        const f32x4 lv = *(const LAS f32x4*)(scr + 4 * g);
        const f32x4 rl = (f32x4){__builtin_amdgcn_rcpf(lv.x), __builtin_amdgcn_rcpf(lv.y), __builtin_amdgcn_rcpf(lv.z), __builtin_amdgcn_rcpf(lv.w)};
#pragma unroll
        for (int cb = 0; cb < 16; ++cb) o[cb] = o[cb] * rl; }
    LAS f32x4* xch = (LAS f32x4*)(lds + (wid & 1) * 65536) + lane;
    if (act && mp == 1) {
#pragma unroll
        for (int cb = 0; cb < 16; ++cb) xch[cb * 64] = o[cb]; }
    __syncthreads();
    if (act && mp == 0) {
        f32x4 ss = (f32x4){0.f, 0.f, 0.f, 0.f};
#pragma unroll
        for (int cb = 0; cb < 16; ++cb) { const f32x4 o1 = xch[cb * 64]; o[cb] = o[cb] - o1 * lam; ss = ss + o[cb] * o[cb]; }
#pragma unroll
        for (int m = 1; m < 16; m <<= 1) { ss.x += __shfl_xor(ss.x, m); ss.y += __shfl_xor(ss.y, m); ss.z += __shfl_xor(ss.z, m); ss.w += __shfl_xor(ss.w, m); }
        const f32x4 r = (f32x4){1.0f / sqrtf(ss.x * (1.0f / 256.0f) + EPS), 1.0f / sqrtf(ss.y * (1.0f / 256.0f) + EPS), 1.0f / sqrtf(ss.z * (1.0f / 256.0f) + EPS), 1.0f / sqrtf(ss.w * (1.0f / 256.0f) + EPS)};
        bf16* Ow = OAb + (size_t)(r0 + 4 * g) * 2048 + q16;
#pragma unroll
        for (int cb = 0; cb < 16; ++cb) { const f32x4 v = o[cb] * r;
            Ow[cb * 16] = (bf16)(pk2(v.x, 0.f) & 0xffffu); Ow[2048 + cb * 16] = (bf16)(pk2(v.y, 0.f) & 0xffffu); Ow[2 * 2048 + cb * 16] = (bf16)(pk2(v.z, 0.f) & 0xffffu); Ow[3 * 2048 + cb * 16] = (bf16)(pk2(v.w, 0.f) & 0xffffu); }
    }
}
}

static __device__ const unsigned char ATT_ORDER[8][128] = {
    {63,127,62,126,61,125,60,124,59,123,58,122,57,121,56,120,55,119,54,118,53,117,52,116,51,115,85,86,87,88,89,90,91,92,93,94,95,50,114,84,83,49,113,82,81,48,80,112,47,79,111,46,78,110,45,77,109,44,76,108,43,75,107,42,74,106,41,73,105,40,72,104,39,71,103,38,70,102,37,69,101,36,68,100,35,67,99,4,5,6,7,8,9,10,11,12,13,14,15,16,17,18,19,20,21,22,23,24,25,26,27,28,29,30,31,3,2,34,66,98,1,33,65,97,0,32,64,96},
    {63,127,62,126,61,125,60,124,59,123,58,122,57,121,56,120,55,119,54,118,53,117,52,116,51,115,50,114,49,113,48,112,47,111,46,110,45,109,44,108,43,107,42,106,75,76,77,78,79,80,81,82,83,84,85,86,87,88,89,90,91,92,93,94,95,41,105,74,73,40,72,104,39,71,103,38,70,102,37,69,101,6,7,8,9,10,11,12,13,14,15,16,17,18,19,20,21,22,23,24,25,26,27,28,29,30,31,5,4,36,68,100,3,35,67,99,2,34,66,98,1,33,65,97,0,32,64,96},
    {63,127,62,126,61,125,60,124,59,123,58,122,57,121,56,120,55,119,54,118,53,117,52,116,51,115,50,114,49,113,48,112,47,111,46,110,45,109,44,108,43,107,42,106,11,12,13,14,15,16,17,18,19,20,21,22,23,24,25,26,27,28,29,30,31,41,105,10,9,8,40,104,7,39,103,6,38,102,5,37,101,70,71,72,73,74,75,76,77,78,79,80,81,82,83,84,85,86,87,88,89,90,91,92,93,94,95,69,4,36,68,100,3,35,67,99,2,34,66,98,1,33,65,97,0,32,64,96},
    {63,127,62,126,61,125,60,124,59,123,58,122,57,121,56,120,55,119,54,118,53,117,52,116,51,115,21,22,23,24,25,26,27,28,29,30,31,50,114,20,19,49,113,18,17,16,48,112,15,47,111,14,46,110,13,45,109,12,44,108,11,43,107,10,42,106,9,41,105,8,40,104,7,39,103,6,38,102,5,37,101,4,36,100,3,35,99,68,69,70,71,72,73,74,75,76,77,78,79,80,81,82,83,84,85,86,87,88,89,90,91,92,93,94,95,67,2,34,66,98,1,33,65,97,0,32,64,96},
    {31,95,30,94,29,93,28,92,27,91,26,90,25,89,24,88,23,87,22,86,21,85,20,84,19,83,53,54,55,56,57,58,59,60,61,62,63,18,82,52,51,17,81,50,49,16,48,80,15,47,79,14,46,78,13,45,77,12,44,76,11,43,75,10,42,74,9,41,73,8,40,72,7,39,71,6,38,70,5,37,69,4,36,68,3,35,67,100,101,102,103,104,105,106,107,108,109,110,111,112,113,114,115,116,117,118,119,120,121,122,123,124,125,126,127,99,2,34,66,98,1,33,65,97,0,32,64,96},
    {31,95,30,94,29,93,28,92,27,91,26,90,25,89,24,88,23,87,22,86,21,85,20,84,19,83,18,82,17,81,16,80,15,79,14,78,13,77,12,76,11,75,10,74,43,44,45,46,47,48,49,50,51,52,53,54,55,56,57,58,59,60,61,62,63,9,73,42,41,8,40,72,7,39,71,6,38,70,5,37,69,102,103,104,105,106,107,108,109,110,111,112,113,114,115,116,117,118,119,120,121,122,123,124,125,126,127,101,4,36,68,100,3,35,67,99,2,34,66,98,1,33,65,97,0,32,64,96},
    {31,95,30,94,29,93,28,92,27,91,26,90,25,89,24,88,23,87,22,86,21,85,20,84,19,83,18,82,17,81,16,80,15,79,14,78,13,77,12,76,11,75,10,74,107,108,109,110,111,112,113,114,115,116,117,118,119,120,121,122,123,124,125,126,127,9,73,106,105,8,72,104,7,71,103,6,70,102,5,69,101,38,39,40,41,42,43,44,45,46,47,48,49,50,51,52,53,54,55,56,57,58,59,60,61,62,63,37,4,36,68,100,3,35,67,99,2,34,66,98,1,33,65,97,0,32,64,96},
    {31,95,30,94,29,93,28,92,27,91,26,90,25,89,24,88,23,87,22,86,21,85,20,84,19,83,117,118,119,120,121,122,123,124,125,126,127,18,82,116,115,17,81,114,113,16,80,112,15,79,111,14,78,110,13,77,109,12,76,108,11,75,107,10,74,106,9,73,105,8,72,104,7,71,103,6,70,102,5,69,101,4,68,100,3,67,99,36,37,38,39,40,41,42,43,44,45,46,47,48,49,50,51,52,53,54,55,56,57,58,59,60,61,62,63,35,2,34,66,98,1,33,65,97,0,32,64,96},
};
#ifndef WGM_G1
#define WGM_G1 4
#endif
#ifndef WGM_G3
#define WGM_G3 4
#endif
#ifndef WGM_G4
#define WGM_G4 4
#endif
#ifndef HID_PAD
#define HID_PAD 0
#endif
constexpr int HP = FF + HID_PAD;
constexpr int N_PHASES = 1 + 4 * 8 + 1 - 1 - 2;
#ifndef ATT_SD
#define ATT_SD 2
#endif
struct Params { const float* in[19]; float* out; unsigned char* ws; float lam0, lam1; int ph_lo, ph_hi, li, pad; };

__global__ void __launch_bounds__(512, 2) yoco_fwd(Params P) {
    extern __shared__ __attribute__((aligned(16))) unsigned char lds_raw[];
    LAS unsigned char* lds = (LAS unsigned char*)lds_raw;
    volatile LAS unsigned* MISC = (volatile LAS unsigned*)(lds + MISC_OFF);
    if (threadIdx.x < 128) MISC[threadIdx.x] = 0u;
    __syncthreads();
    unsigned* ctl = (unsigned*)(P.ws + WS_CTL);
    XcdBarrier bar = xcd_barrier_post(ctl + CW_BAR + P.li * XCD_BAR_WORDS, MISC + 8);
    const int lo = P.ph_lo, hi = P.ph_hi; int pc = 0;
#define PHASE_BEGIN if (pc >= lo && pc < hi) { PTRS
#define PHASE_END   if (pc + 1 < hi) xcd_barrier(bar); } ++pc;
#ifndef PROBE_MASK
#define PROBE_MASK 0
#endif
#if PROBE_MASK
#define REP_BEGIN(bit) for (int rep_ = 0, nrep_ = ((P.pad >> (bit)) & 1) + 1; rep_ < nrep_; ++rep_) {
#define REP_END if (rep_ + 1 < nrep_) xcd_barrier(bar); }
#else
#define REP_BEGIN(bit) {
#define REP_END }
#endif
#define PTRS size_t wz_ = 0; asm volatile("" : "+s"(wz_)); unsigned char* ws = P.ws + wz_; int tid = threadIdx.x; asm volatile("" : "+v"(tid)); int bx = blockIdx.x; asm volatile("" : "+s"(bx)); int G = gridDim.x; asm volatile("" : "+s"(G)); \
    const int lane = tid & 63, wave = __builtin_amdgcn_readfirstlane(tid >> 6), gw = bx * 8 + wave, ngw = G * 8; (void)lane; (void)gw; (void)ngw; \
    bf16* XB = (bf16*)(ws + WS_XB); float* RS = (float*)(ws + WS_RS); float* MB = (float*)(ws + WS_M); \
    bf16* R1 = (bf16*)(ws + WS_R1); bf16* R2 = (bf16*)(ws + WS_R2); bf16* R3 = (bf16*)(ws + WS_R3); bf16* QB = R3 + (size_t)MT * DM; \
    bf16* KpB = (bf16*)(ws + WS_KP); bf16* VpB = (bf16*)(ws + WS_VP); bf16* KsB = (bf16*)(ws + WS_KS); bf16* VsB = (bf16*)(ws + WS_VS); \
    float* Y = P.out + wz_ + OUT_Y; (void)XB; (void)RS; (void)MB; (void)R1; (void)R2; (void)R3; (void)QB; (void)KpB; (void)VpB; (void)KsB; (void)VsB; (void)Y;
#define INP(k) ({ int kk_ = (k); asm volatile("" : "+s"(kk_)); P.in[kk_]; })

    PHASE_BEGIN
    REP_BEGIN(2)
    {
#ifndef NO_P0
        LAS float* scr = (LAS float*)(lds + wave * 17408);
        tr_matrix(INP(9), DM, 6 * DM, (bf16*)(ws + WS_WIN), INP(5), DM - 1, 1.f, 2048, 4096, 0.0625f, scr, gw, ngw, lane);
        tr_matrix(INP(10), 2 * DM, DM, (bf16*)(ws + WS_WRO), nullptr, 0, 1.f, 0, 0, 1.f, scr, gw, ngw, lane);
        for (int l = 0; l < 2; ++l) {
            tr_matrix(INP(17) + (size_t)l * DM * FF, DM, FF, (bf16*)(ws + WS_WUP + l * SZ_WUP), INP(7) + l * DM, DM - 1, 1.f, 0, 0, 1.f, scr, gw, ngw, lane);
            tr_matrix(INP(18) + (size_t)l * FF * DM, FF, DM, (bf16*)(ws + WS_WDN + l * SZ_WDN), nullptr, 0, 1.f, 0, 0, 1.f, scr, gw, ngw, lane);
        }
        static_assert(256 * (SEQ / 64) * 4 * 1024 == DB * PAST * DM, "the cache K/V -> bf16 conversion rides in the retention phases (ret::Seq::cvt_src)");
        for (int r = gw; r < 2 * DB * 96; r += ngw) { const int t = r / (DB * 96), rr = r - t * (DB * 96), b = rr / 96, p = rr - b * 96;
            v4u* d = (v4u*)((t ? VsB : KsB) + ((size_t)b * SKV_S + 1056 + p) * DM) + lane;
#pragma unroll
            for (int j = 0; j < 4; ++j) d[64 * j] = (v4u){0u, 0u, 0u, 0u}; }
        for (int r = gw; r < MT; r += ngw) { const float* src = r < MP ? INP(0) + (size_t)r * DM : INP(1) + (size_t)(r - MP) * DM;
            x_init_row(src, XB + (size_t)r * DM, RS + r, lane); }
#endif
    }
    REP_END
    PHASE_END

    for (int l = 0; l < 4; ++l) {
        const bool retl = l < 2; const int j = l - 2;
        if (l != 2) {
        PHASE_BEGIN
        REP_BEGIN(0)
        if (retl) {
            pg8::Gemm g{XB, (const bf16*)(ws + WS_WIN + l * SZ_WIN), MT, 6 * DM, DM, DM};
            pg8::StaticOrder S; S.init(MT, 6 * DM, G, bx, WGM_G1);
            pg8::EpiProj E{R1, RS};
#ifndef NO_GEMM0
            pg8::gemm_phase<pg8::EpiProj, pg8::StaticOrder, true, true>(lds, g, S, E);
#endif
            { const int nwg_ = (MT / 256) * (6 * DM / 256), rem_ = nwg_ - (nwg_ / G) * G;
              if (l == 1 && rem_ > 0 && bx >= rem_) { LAS float* scr = (LAS float*)(lds + wave * 17408); const int tgw = (bx - rem_) * 8 + wave, tng = (G - rem_) * 8;
                tr_matrix(INP(10) + (size_t)2 * DM * DM, 2 * DM, DM, (bf16*)(ws + WS_WRO + SZ_WRO), nullptr, 0, 1.f, 0, 0, 1.f, scr, tgw, tng, lane); } }
        } else {
            pg8::Gemm g{XB, (const bf16*)(ws + WS_WQ + j * SZ_WQ), MT, DM, DM, DM};
            pg8::StaticOrder S; S.init(MT, DM, G, bx);
            pg8::EpiBf16Rs<0> E{QB, DM, RS};
#ifndef NO_GEMM1
            pg8::gemm_phase<pg8::EpiBf16Rs<0>, pg8::StaticOrder, true, true>(lds, g, S, E);
#endif
            { const int nwg_ = (MT / 256) * (DM / 256), rem_ = nwg_ - (nwg_ / G) * G;
              if (rem_ > 0 && bx >= rem_) { LAS float* scr = (LAS float*)(lds + wave * 17408); const int tgw = (bx - rem_) * 8 + wave, tng = (G - rem_) * 8;
                tr_matrix(INP(18) + (size_t)3 * FF * DM, FF, DM, (bf16*)(ws + WS_WDN + 3 * SZ_WDN), nullptr, 0, 1.f, 0, 0, 1.f, scr, tgw, tng, lane); } }
        }
        REP_END
        PHASE_END
        }
        PHASE_BEGIN
        REP_BEGIN(retl ? 4 : 5)
        if (retl) {
            const int vx = (G & 7) ? bx : (bx & 7) * (G >> 3) + (bx >> 3);
            for (int u = vx; u < 256 + 2048; u += G) {
                ret::Seq sq; int h, s;
                if (u < 256) { const int b = u >> 6; h = (u >> 3) & 7; s = u & 7;
                    sq.proj = R1 + (size_t)b * SEQ * 6 * DM; sq.oret = R2 + (size_t)b * SEQ * 2 * DM; sq.S0 = nullptr;
                    sq.Sout = P.out + OUT_SP + ((size_t)(l * NBP + b) * NH + h) * (DK * DV); sq.nchunks = SEQ / 64; sq.pad = 0;
                    sq.cvt_src = INP(3 + l); sq.cvt_dst = l ? VsB : KsB; sq.cvt_chunk0 = u * 256; }
                else { const int su = u - 256, b = su >> 6; h = (su >> 3) & 7; s = su & 7; const size_t row0 = (size_t)MP + b * DS;
                    sq.proj = R1 + row0 * 6 * DM; sq.oret = R2 + row0 * 2 * DM; sq.S0 = INP(2) + ((size_t)(l * DB + b) * NH + h) * (DK * DV);
                    sq.Sout = P.out + OUT_SS + ((size_t)(l * DB + b) * NH + h) * (DK * DV); sq.nchunks = 1; sq.pad = 32; sq.cvt_src = nullptr; sq.cvt_dst = nullptr; sq.cvt_chunk0 = 0; }
                const float xg = __builtin_amdgcn_exp2f((float)(-5 - h));
                const float l2g = -1.4426950408889634f * (xg * (1.f + xg * (0.5f + xg * (0.33333334f + xg * (0.25f + xg * 0.2f)))));
#ifndef NO_RET
                ret::unit(sq, h, s, l2g, lds);
#endif
            }
        } else {
            const float* dl = INP(14) + j * 512;
            const float s1 = wave_sum(dl[lane] * dl[128 + lane] + dl[64 + lane] * dl[192 + lane]);
            const float s2 = wave_sum(dl[256 + lane] * dl[384 + lane] + dl[320 + lane] * dl[448 + lane]);
            const float lam = __expf(s1) - __expf(s2) + (j ? P.lam1 : P.lam0);
#ifndef NO_ATT
            unsigned* qc = ctl + CW_ATTQ + j * 256;
            const int xq = bx & 7;
            int nxt = -1;
#define ATT_FETCH() do { if (tid == 0) { nxt = -1; unsigned i_ = atomicAdd(qc + xq * 16, 1u); \
                    if (i_ < 128u) nxt = (xq << 7) | ATT_ORDER[xq][i_]; \
                    else { i_ = atomicAdd(qc + 128, 1u); if (i_ < 256u) nxt = 1024 + (int)i_; \
                        else for (int d_ = 1; d_ < 8 && nxt < 0; ++d_) { const int y_ = (xq + d_) & 7; i_ = atomicAdd(qc + y_ * 16, 1u); if (i_ < 128u) nxt = (y_ << 7) | ATT_ORDER[y_][i_]; } } } } while (0)
            ATT_FETCH();
            for (;;) {
                if (tid == 0) MISC[16] = (unsigned)nxt;
                __syncthreads();
                const int u = (int)MISC[16];
                if (u < 0) break;
                ATT_FETCH();
                int h, b, NT, qpos0, klim; size_t row0; const bf16* Kb; const bf16* Vb; bool act; const bool prm = u < 1024;
                if (prm) { const int qb = u & 31; b = (u >> 5) & 3; h = (u >> 7) ^ (b == 0 ? 0 : b == 1 ? 7 : b == 2 ? 3 : 4);
                    row0 = (size_t)b * SEQ + qb * 128;
                    Kb = KpB + (size_t)b * SEQ * DM; Vb = VpB + (size_t)b * SEQ * DM; NT = 2 * qb + 2; qpos0 = qb * 128; klim = (2 * qb + (wave >> 2) + 1) * 64; act = true; }
                else { const int su = u - 1024; h = su & 7; b = su >> 3; row0 = (size_t)MP + b * DS;
                    Kb = KsB + (size_t)b * SKV_S * DM; Vb = VsB + (size_t)b * SKV_S * DM; NT = 18; qpos0 = PAST; klim = PAST + DS; act = (wave < 2); }
                const float nb = -__builtin_amdgcn_exp2f((float)(-(h + 1))) * 11.313708498984761f;
                if (prm) a16::attn_pair<false>(QB + row0 * DM + h * 256, Kb + h * 256, Vb + h * 256, R3 + row0 * DM + h * 256, NT, qpos0, klim, act, nb, lam, lds, ctl + CW_KMAX + (b * 16 + h * 2) * 4);
                else a16::attn_sample2(QB + row0 * DM + h * 256, Kb + h * 256, Vb + h * 256, R3 + row0 * DM + h * 256, NT, qpos0, klim, nb, lam, lds);
            }
#undef ATT_FETCH
#endif
        }
        REP_END
        PHASE_END
        if (retl) {
        PHASE_BEGIN
        REP_BEGIN(3)
        {
            static_assert((MT * NH) % 4 == 0, "gate batching");
            for (int it = gw; it < MT * NH / 4; it += ngw) {
                const bf16* o_[4]; const bf16* g_[4]; bf16* og_[4];
#pragma unroll
                for (int n = 0; n < 4; ++n) { const int id = it * 4 + n; const size_t row = id >> 3; const int h = id & 7;
                    o_[n] = R2 + row * 2 * DM + h * 512; g_[n] = R1 + row * 6 * DM + 8192 + h * 512; og_[n] = R3 + row * 2 * DM + h * 512; }
                gate_items<4>(o_, g_, og_, lane); }
        }
        REP_END
        PHASE_END
        }
        PHASE_BEGIN
        REP_BEGIN(0)
        if (retl) {
            const bf16* Bt = (const bf16*)(ws + WS_WRO + l * SZ_WRO);
            { pg8::Gemm g{R3, Bt, MP, DM, 2 * DM, 2 * DM}; pg8::StaticOrder S; S.init(MP, DM, G, bx); pg8::EpiBf16Plain E{(bf16*)MB, DM};
#ifndef NO_GEMM2
              pg8::gemm_phase<pg8::EpiBf16Plain, pg8::StaticOrder, true, true>(lds, g, S, E);
#endif
            }
            { const int ks = bx & 7; pg8::Gemm g{R3 + (size_t)MP * 2 * DM + ks * (2 * DM / 8), Bt + ks * (2 * DM / 8), MS, DM, 2 * DM / 8, 2 * DM}; pg8::SplitOrder S{G, bx}; pg8::EpiF32 E{(float*)R2 + (size_t)ks * MS * DM, DM};
#ifndef NO_GEMM2
              pg8::gemm_phase<pg8::EpiF32, pg8::SplitOrder, true, true>(lds, g, S, E);
#endif
            }
        } else {
            const bf16* Bt = (const bf16*)(ws + WS_WO + j * SZ_WQ);
            { pg8::Gemm g{R3, Bt, MP, DM, DM, DM}; pg8::StaticOrder S; S.init(MP, DM, G, bx); pg8::EpiBf16Plain E{(bf16*)MB, DM};
#ifndef NO_GEMM3
              pg8::gemm_phase<pg8::EpiBf16Plain, pg8::StaticOrder, true, true>(lds, g, S, E);
#endif
            }
            { const int ks = bx & 7; pg8::Gemm g{R3 + (size_t)MP * DM + ks * (DM / 8), Bt + ks * (DM / 8), MS, DM, DM / 8, DM}; pg8::SplitOrder S{G, bx}; pg8::EpiF32 E{(float*)R2 + (size_t)ks * MS * DM, DM};
#ifndef NO_GEMM3
              pg8::gemm_phase<pg8::EpiF32, pg8::SplitOrder, true, true>(lds, g, S, E);
#endif
            }
        }
        REP_END
        PHASE_END
        PHASE_BEGIN
        { float gv[4][8]; load_gains(gv, INP(6) + l * DM, lane);
        for (int r = gw; r < MT; r += ngw) res_row(XB + (size_t)r * DM, r < MP ? (const bf16*)MB + (size_t)r * DM : nullptr, (const float*)R2 + (size_t)(r - MP) * DM, gv, RS + r, nullptr, lane); }
        PHASE_END
        PHASE_BEGIN
        REP_BEGIN(6)
        {
            pg8::Gemm g{XB, (const bf16*)(ws + WS_WUP + l * SZ_WUP), MT, FF, DM, DM};
            pg8::StaticOrder S; S.init(MT, FF, G, bx, WGM_G3);
            pg8::EpiBf16Rs<1> E{R1, HP, RS};
#ifndef NO_GEMM4
            pg8::gemm_phase<pg8::EpiBf16Rs<1>, pg8::StaticOrder, true, true>(lds, g, S, E);
#endif
            { const int nwg_ = (MT / 256) * (FF / 256), rem_ = nwg_ - (nwg_ / G) * G;
              if (rem_ > 0 && bx >= rem_ && l < 3) { LAS float* scr = (LAS float*)(lds + wave * 17408); const int tgw = (bx - rem_) * 8 + wave, tng = (G - rem_) * 8;
                if (l == 0) {
                    tr_matrix(INP(9) + (size_t)DM * 6 * DM, DM, 6 * DM, (bf16*)(ws + WS_WIN + SZ_WIN), INP(5) + DM, DM - 1, 1.f, 2048, 4096, 0.0625f, scr, tgw, tng, lane);
                } else if (l == 1) {
                    tr_matrix(INP(12), DM, 2 * DM, (bf16*)(ws + WS_WKV), INP(11), DM - 1, 1.f, 0, 0, 1.f, scr, tgw, tng, lane);
                    for (int jj = 0; jj < 2; ++jj) {
                        tr_matrix(INP(13) + (size_t)jj * DM * DM, DM, DM, (bf16*)(ws + WS_WQ + jj * SZ_WQ), INP(5) + (2 + jj) * DM, DM - 1, 1.f, 0, 0, 1.f, scr, tgw, tng, lane);
                        tr_matrix(INP(16) + (size_t)jj * DM * DM, DM, DM, (bf16*)(ws + WS_WO + jj * SZ_WQ), INP(15) + jj * 256, 255, 1.f - (jj ? P.lam1 : P.lam0), 0, 0, 1.f, scr, tgw, tng, lane);
                    }
                } else {
                    tr_matrix(INP(17) + (size_t)3 * DM * FF, DM, FF, (bf16*)(ws + WS_WUP + 3 * SZ_WUP), INP(7) + 3 * DM, DM - 1, 1.f, 0, 0, 1.f, scr, tgw, tng, lane);
                } } }
        }
        REP_END
        PHASE_END
        PHASE_BEGIN
        REP_BEGIN(0)
        {
            const bf16* Bt = (const bf16*)(ws + WS_WDN + l * SZ_WDN);
            { pg8::Gemm g{R1, Bt, MP, DM, FF, HP, FF}; pg8::StaticOrder S; S.init(MP, DM, G, bx, WGM_G4); pg8::EpiBf16Plain E{(bf16*)MB, DM};
#ifndef NO_GEMM5
              pg8::gemm_phase<pg8::EpiBf16Plain, pg8::StaticOrder, true, true>(lds, g, S, E);
#endif
            }
            { const int ks = bx & 7; pg8::Gemm g{R1 + (size_t)MP * HP + ks * (FF / 8), Bt + ks * (FF / 8), MS, DM, FF / 8, HP, FF}; pg8::SplitOrder S{G, bx}; pg8::EpiF32 E{(float*)R2 + (size_t)ks * MS * DM, DM};
#ifndef NO_GEMM5
              pg8::gemm_phase<pg8::EpiF32, pg8::SplitOrder, true, true>(lds, g, S, E);
#endif
            }
        }
        REP_END
        PHASE_END
        PHASE_BEGIN
        { float gv[4][8]; load_gains(gv, INP(8) + l * DM, lane);
        for (int r = gw; r < MT; r += ngw) res_row(XB + (size_t)r * DM, r < MP ? (const bf16*)MB + (size_t)r * DM : nullptr, (const float*)R2 + (size_t)(r - MP) * DM, gv, RS + r, l == 3 ? Y + (size_t)r * DM : nullptr, lane); }
        PHASE_END
        if (l == 1) {
            PHASE_BEGIN
            REP_BEGIN(0)
            {
                static_assert(WS_WQ == WS_WKV + SZ_WKV, "Wkv_t and Wq_t[0] are one [6144][2048] operand");
                pg8::Gemm g{XB, (const bf16*)(ws + WS_WKV), MT, 3 * DM, DM, DM};
                pg8::StaticOrder S; S.init(MT, 3 * DM, G, bx);
                pg8::EpiKVQ E{pg8::EpiKV{P.out + OUT_KP, P.out + OUT_VP, P.out + OUT_KS, P.out + OUT_VS, KpB, VpB, KsB, VsB, RS, ctl + CW_KMAX}, pg8::EpiBf16Rs<0>{QB, DM, RS}};
#ifndef NO_GEMM6
                pg8::gemm_phase<pg8::EpiKVQ, pg8::StaticOrder, true, true>(lds, g, S, E);
#endif
                { const int nwg_ = (MT / 256) * (3 * DM / 256), rem_ = nwg_ - (nwg_ / G) * G;
                  if (rem_ > 0 && bx >= rem_) { LAS float* scr = (LAS float*)(lds + wave * 17408); const int tgw = (bx - rem_) * 8 + wave, tng = (G - rem_) * 8;
                    tr_matrix(INP(17) + (size_t)2 * DM * FF, DM, FF, (bf16*)(ws + WS_WUP + 2 * SZ_WUP), INP(7) + 2 * DM, DM - 1, 1.f, 0, 0, 1.f, scr, tgw, tng, lane);
                    tr_matrix(INP(18) + (size_t)2 * FF * DM, FF, DM, (bf16*)(ws + WS_WDN + 2 * SZ_WDN), nullptr, 0, 1.f, 0, 0, 1.f, scr, tgw, tng, lane); } }
            }
            REP_END
            PHASE_END
        }
    }
#undef PHASE_BEGIN
#undef PHASE_END
}

extern "C" void kernel_launch(void* const* d_in, const int* in_sizes, int n_in, void* d_out, int out_size, void* d_ws, size_t ws_size, hipStream_t stream) {
    static int grid = 0;
    if (grid == 0) {
        if (n_in != 19 || (size_t)out_size != OUT_END || ws_size < WS_END) { fprintf(stderr, "kernel_launch: shape mismatch: n_in %d out %d ws %zu (need %zu)\n", n_in, out_size, ws_size, (size_t)WS_END); grid = -1; return; }
        int dev = 0, cus = 0, per_cu = 0;
        if (hipGetDevice(&dev) != hipSuccess || hipDeviceGetAttribute(&cus, hipDeviceAttributeMultiprocessorCount, dev) != hipSuccess) { grid = -1; return; }
        if (hipFuncSetAttribute((const void*)yoco_fwd, hipFuncAttributeMaxDynamicSharedMemorySize, LDS_BYTES) != hipSuccess) { fprintf(stderr, "kernel_launch: hipFuncSetAttribute failed\n"); grid = -1; return; }
        if (hipOccupancyMaxActiveBlocksPerMultiprocessor(&per_cu, (const void*)yoco_fwd, 512, LDS_BYTES) != hipSuccess || per_cu < 1) { fprintf(stderr, "kernel_launch: occupancy query says %d blocks per CU\n", per_cu); }
        (void)hipGetLastError();
        grid = cus;
    }
    if (grid < 0) return;
    if (hipMemsetAsync((char*)d_ws + WS_CTL, 0, MK_PER_PHASE ? CTL_ZERO_BYTES : (size_t)(CW_BAR + XCD_BAR_WORDS) * 4, stream) != hipSuccess) { fprintf(stderr, "kernel_launch: memset failed\n"); return; }
    Params p{};
    for (int i = 0; i < 19; ++i) p.in[i] = (const float*)d_in[i];
    p.out = (float*)d_out; p.ws = (unsigned char*)d_ws;
    p.lam0 = (float)(0.8 - 0.6 * exp(-0.3 * 2.0)); p.lam1 = (float)(0.8 - 0.6 * exp(-0.3 * 3.0));
#if MK_PER_PHASE
    for (int li = 0; li < N_PHASES; ++li) { p.ph_lo = li; p.ph_hi = li + 1; p.li = li; p.pad = 0;
        hipLaunchKernelGGL(yoco_fwd, dim3(grid), dim3(512), LDS_BYTES, stream, p); }
#else
    p.ph_lo = 0; p.ph_hi = N_PHASES; p.li = 0; p.pad = PROBE_MASK;
    hipLaunchKernelGGL(yoco_fwd, dim3(grid), dim3(512), LDS_BYTES, stream, p);
#endif
    const hipError_t le = hipPeekAtLastError();
    if (le != hipSuccess) fprintf(stderr, "kernel_launch: launch failed: %s\n", hipGetErrorName(le));
}
```
